# Optimizing an MI355X kernel written in HIP

```python
import jax
import jax.numpy as jnp
from jax import lax
import numpy as np

D_MODEL = 2048
BATCH = 8
SEQ = 4096
DEPTH = 4

CTX_LEN = 256
GRID_W = 64
HEAD_DIM = 128
A_HEADS = D_MODEL // 2 // HEAD_DIM
A_KV_HEADS = 2
B_HEADS = D_MODEL // 4 // HEAD_DIM
B_KV_HEADS = 2
F_GROUPS = 4
F_GROUP_DIM = D_MODEL // 4 // F_GROUPS
WINDOW = 128
Q_BLOCK = 128
D_FF = 5632
CONV_W = 3
ROPE_BASE = 10000.0
EPS = 1e-6
NEG_INF = -1e30
DEEPNORM_ALPHA = (2.0 * DEPTH) ** 0.25
DEEPNORM_BETA = (8.0 * DEPTH) ** -0.25

QA_W = A_HEADS * HEAD_DIM
QB_W = B_HEADS * HEAD_DIM
KA_W = A_KV_HEADS * HEAD_DIM
KB_W = B_KV_HEADS * HEAD_DIM
F_WIDTH = F_GROUPS * F_GROUP_DIM
MIX_WIDTH = QA_W + QB_W + F_WIDTH
IN_SIZES = (QA_W, QB_W, KA_W, KA_W, KB_W, KB_W, F_WIDTH)
KV_SIZES = (KA_W, KA_W, KB_W, KB_W)
IN_WIDTH = QA_W + QB_W + 2 * KA_W + 2 * KB_W + F_WIDTH
KV_START = QA_W + QB_W
KV_END = KV_START + 2 * KA_W + 2 * KB_W

kernel_name = 'hybrid_flow_backbone_parallel_heads'


def _split(t, sizes):
    out, start = [], 0
    for s in sizes:
        out.append(t[..., start:start + s])
        start += s
    return out


def _heads(t, n_heads):
    return t.reshape(t.shape[:-1] + (n_heads, HEAD_DIM))


def layer_norm(t, gain=None, bias=None):
    tf = t.astype(jnp.float32)
    mu = jnp.mean(tf, -1, keepdims=True)
    var = jnp.mean(jnp.square(tf - mu), -1, keepdims=True)
    y = (tf - mu) * lax.rsqrt(var + EPS)
    if gain is not None:
        y = y * gain.astype(jnp.float32) + bias.astype(jnp.float32)
    return y.astype(t.dtype)


def rms_norm(t, gain):
    tf = t.astype(jnp.float32)
    y = tf * lax.rsqrt(jnp.mean(tf * tf, -1, keepdims=True) + EPS) * gain.astype(jnp.float32)
    return y.astype(t.dtype)


def modulate(t, shift, scale):
    return layer_norm(t) * (1.0 + scale) + shift


def axial_rope_tables(n_tokens):
    rows = n_tokens // GRID_W
    row = jnp.repeat(jnp.arange(rows), GRID_W).astype(jnp.float32)
    col = jnp.tile(jnp.arange(GRID_W), rows).astype(jnp.float32)
    n_freq = HEAD_DIM // 4
    inv_freq = ROPE_BASE ** (-jnp.arange(n_freq, dtype=jnp.float32) / n_freq)
    ang = jnp.stack([row[:, None] * inv_freq, col[:, None] * inv_freq], axis=1)
    return jnp.cos(ang), jnp.sin(ang)


def apply_rope(t, cos, sin):
    n_freq = HEAD_DIM // 4
    tf = t.astype(jnp.float32).reshape(t.shape[:-1] + (2, 2, n_freq))
    a, b = tf[..., 0, :], tf[..., 1, :]
    c = cos[None, :, None]
    s = sin[None, :, None]
    out = jnp.stack([a * c - b * s, a * s + b * c], axis=-2)
    return out.reshape(t.shape).astype(t.dtype)


def softmax_with_sink(s, sink):
    m = jnp.maximum(jnp.max(s, -1, keepdims=True), sink)
    e = jnp.exp(s - m)
    return e / (jnp.sum(e, -1, keepdims=True) + jnp.exp(sink - m))


def context_attention(q, k, v, sink=None):
    bsz, n_ctx, n_heads, d = q.shape
    n_kv = k.shape[2]
    qg = q.reshape(bsz, n_ctx, n_kv, n_heads // n_kv, d)
    s = jnp.einsum('bqkgd,bskd->bkgqs', qg, k).astype(jnp.float32) * (d ** -0.5)
    if sink is None:
        p = jax.nn.softmax(s, -1)
    else:
        p = softmax_with_sink(s, sink.astype(jnp.float32).reshape(n_kv, -1)[None, :, :, None, None])
    o = jnp.einsum('bkgqs,bskd->bqkgd', p.astype(v.dtype), v)
    return o.reshape(bsz, n_ctx, n_heads * d)


def global_attention_latent(q, k, v, k_ctx, v_ctx):
    bsz, n_tok, n_heads, d = q.shape
    n_grp = n_heads // A_KV_HEADS
    n_blk = n_tok // Q_BLOCK
    kk = jnp.concatenate([k, k_ctx], axis=1)
    vv = jnp.concatenate([v, v_ctx], axis=1)
    qb = q.reshape(bsz, n_blk, Q_BLOCK, A_KV_HEADS, n_grp, d).transpose(1, 0, 2, 3, 4, 5)
    scale = d ** -0.5

    def block(qi):
        s = jnp.einsum('bqkgd,bskd->bkgqs', qi, kk).astype(jnp.float32) * scale
        p = jax.nn.softmax(s, -1).astype(vv.dtype)
        return jnp.einsum('bkgqs,bskd->bqkgd', p, vv)

    o = lax.map(block, qb)
    return o.transpose(1, 0, 2, 3, 4, 5).reshape(bsz, n_tok, n_heads * d)


def window_attention_latent(q, k, v, k_ctx, v_ctx, sink):
    bsz, n_tok, n_heads, d = q.shape
    n_grp = n_heads // B_KV_HEADS
    n_blk = n_tok // Q_BLOCK
    qb = q.reshape(bsz, n_blk, Q_BLOCK, B_KV_HEADS, n_grp, d)

    def band(t):
        tb = t.reshape(bsz, n_blk, Q_BLOCK, B_KV_HEADS, d)
        tp = jnp.pad(tb, ((0, 0), (1, 1), (0, 0), (0, 0), (0, 0)))
        return jnp.concatenate([tp[:, :-2], tp[:, 1:-1], tp[:, 2:]], axis=2)

    kb, vb = band(k), band(v)
    qpos = jnp.arange(n_tok).reshape(n_blk, Q_BLOCK)
    kpos = (jnp.arange(n_blk)[:, None] - 1) * Q_BLOCK + jnp.arange(3 * Q_BLOCK)[None, :]
    allowed = ((jnp.abs(qpos[:, :, None] - kpos[:, None, :]) <= WINDOW)
               & (kpos[:, None, :] >= 0) & (kpos[:, None, :] < n_tok))
    scale = d ** -0.5
    s_loc = jnp.einsum('bnqkgd,bnskd->bnkgqs', qb, kb).astype(jnp.float32) * scale
    s_loc = jnp.where(allowed[None, :, None, None], s_loc, NEG_INF)
    s_ctx = jnp.einsum('bnqkgd,bskd->bnkgqs', qb, k_ctx).astype(jnp.float32) * scale
    s = jnp.concatenate([s_loc, s_ctx], axis=-1)
    sink_b = sink.astype(jnp.float32).reshape(B_KV_HEADS, n_grp)[None, None, :, :, None, None]
    p = softmax_with_sink(s, sink_b).astype(v.dtype)
    o = (jnp.einsum('bnkgqs,bnskd->bnqkgd', p[..., :3 * Q_BLOCK], vb)
         + jnp.einsum('bnkgqs,bskd->bnqkgd', p[..., 3 * Q_BLOCK:], v_ctx))
    return o.reshape(bsz, n_tok, n_heads * d)


def fourier_mix(u, w_f):
    bsz, n_tok, _ = u.shape
    ug = u.astype(jnp.float32).reshape(bsz, n_tok, F_GROUPS, F_GROUP_DIM)
    z = jnp.fft.fft2(ug, axes=(1, 3), norm='ortho').real.astype(u.dtype)
    return jnp.einsum('bngc,gce->bnge', z, w_f).reshape(bsz, n_tok, F_WIDTH)


def conv_ffn(h, w_up, w_gate, conv_w, conv_b, w_down):
    n_tok = h.shape[1]
    u = h @ w_up
    g = h @ w_gate
    half = CONV_W // 2
    gp = jnp.pad(g, ((0, 0), (half, half), (0, 0)))
    g = conv_b + sum(gp[:, j:j + n_tok] * conv_w[j] for j in range(CONV_W))
    return (jax.nn.silu(g) * u) @ w_down


def setup_inputs(seed: int = 0) -> dict:
    key = jax.random.key(seed)
    ks = jax.random.split(key, 24)
    D = D_MODEL

    def nrm(k, shape, s):
        return jax.random.normal(k, shape, jnp.float32) * s

    return {
        'x': nrm(ks[0], (BATCH, SEQ, D), 1.0),
        'c': nrm(ks[1], (BATCH, D), 1.0),
        'ctx': nrm(ks[2], (BATCH, CTX_LEN, D), 1.0),
        'c_ctx': nrm(ks[3], (D,), 1.0),
        'w_mod': nrm(ks[4], (DEPTH, D, 6 * D), 0.5 * D ** -0.5),
        'b_mod': nrm(ks[5], (DEPTH, 6 * D), 0.02),
        'w_in': nrm(ks[6], (DEPTH, D, IN_WIDTH), D ** -0.5),
        'q_gain_a': 1.0 + nrm(ks[7], (DEPTH, HEAD_DIM), 0.02),
        'k_gain_a': 1.0 + nrm(ks[8], (DEPTH, HEAD_DIM), 0.02),
        'sink_b': nrm(ks[9], (DEPTH, B_HEADS), 0.5),
        'w_fourier': nrm(ks[10], (DEPTH, F_GROUPS, F_GROUP_DIM, F_GROUP_DIM), F_GROUP_DIM ** -0.5),
        'w_out': nrm(ks[11], (DEPTH, MIX_WIDTH, D), DEEPNORM_BETA * MIX_WIDTH ** -0.5),
        'ln1_g': 1.0 + nrm(ks[12], (DEPTH, D), 0.02),
        'ln1_b': nrm(ks[13], (DEPTH, D), 0.02),
        'w_up': nrm(ks[14], (DEPTH, D, D_FF), D ** -0.5),
        'w_gate': nrm(ks[15], (DEPTH, D, D_FF), D ** -0.5),
        'conv_w': nrm(ks[16], (DEPTH, CONV_W, D_FF), CONV_W ** -0.5),
        'conv_b': nrm(ks[17], (DEPTH, D_FF), 0.02),
        'w_down': nrm(ks[18], (DEPTH, D_FF, D), DEEPNORM_BETA * D_FF ** -0.5),
        'ln2_g': 1.0 + nrm(ks[19], (DEPTH, D), 0.02),
        'ln2_b': nrm(ks[20], (DEPTH, D), 0.02),
    }


def reference(x, c, ctx, c_ctx, w_mod, b_mod, w_in, q_gain_a, k_gain_a, sink_b, w_fourier,
              w_out, ln1_g, ln1_b, w_up, w_gate, conv_w, conv_b, w_down, ln2_g, ln2_b):
    n_tok = x.shape[1]
    cos, sin = axial_rope_tables(n_tok)
    for l in range(DEPTH):
        last = l == DEPTH - 1
        mod = (jax.nn.silu(c) @ w_mod[l] + b_mod[l])[:, None, :]
        sh1, sc1, g1, sh2, sc2, g2 = jnp.split(mod, 6, axis=-1)

        if last:
            mod_c = jax.nn.silu(c_ctx) @ w_mod[l][:, :2 * D_MODEL] + b_mod[l][:2 * D_MODEL]
            csh1, csc1 = jnp.split(mod_c, 2)
            hc = modulate(ctx, csh1, csc1)
            pc_kv = hc @ w_in[l][:, KV_START:KV_END]
        else:
            mod_c = jax.nn.silu(c_ctx) @ w_mod[l] + b_mod[l]
            csh1, csc1, cg1, csh2, csc2, cg2 = jnp.split(mod_c, 6)
            hc = modulate(ctx, csh1, csc1)
            pc = hc @ w_in[l]
            pc_kv = pc[..., KV_START:KV_END]
        kA_c, vA_c, kB_c, vB_c = _split(pc_kv, KV_SIZES)
        kA_c = rms_norm(_heads(kA_c, A_KV_HEADS), k_gain_a[l])
        vA_c = _heads(vA_c, A_KV_HEADS)
        kB_c = _heads(kB_c, B_KV_HEADS)
        vB_c = _heads(vB_c, B_KV_HEADS)

        h = modulate(x, sh1, sc1)
        qA, qB, kA, vA, kB, vB, uF = _split(h @ w_in[l], IN_SIZES)
        qA = apply_rope(rms_norm(_heads(qA, A_HEADS), q_gain_a[l]), cos, sin)
        kA = apply_rope(rms_norm(_heads(kA, A_KV_HEADS), k_gain_a[l]), cos, sin)
        qB = apply_rope(_heads(qB, B_HEADS), cos, sin)
        kB = apply_rope(_heads(kB, B_KV_HEADS), cos, sin)
        oA = global_attention_latent(qA, kA, _heads(vA, A_KV_HEADS), kA_c, vA_c)
        oB = window_attention_latent(qB, kB, _heads(vB, B_KV_HEADS), kB_c, vB_c, sink_b[l])
        oF = fourier_mix(uF, w_fourier[l])
        y = jnp.concatenate([oA, oB, oF], axis=-1) @ w_out[l]
        x = layer_norm(DEEPNORM_ALPHA * x + g1 * y, ln1_g[l], ln1_b[l])
        f = conv_ffn(modulate(x, sh2, sc2), w_up[l], w_gate[l], conv_w[l], conv_b[l], w_down[l])
        x = layer_norm(DEEPNORM_ALPHA * x + g2 * f, ln2_g[l], ln2_b[l])

        if not last:
            qA_c, qB_c, _, _, _, _, uF_c = _split(pc, IN_SIZES)
            oA_c = context_attention(rms_norm(_heads(qA_c, A_HEADS), q_gain_a[l]), kA_c, vA_c)
            oB_c = context_attention(_heads(qB_c, B_HEADS), kB_c, vB_c, sink_b[l])
            oF_c = fourier_mix(uF_c, w_fourier[l])
            yc = jnp.concatenate([oA_c, oB_c, oF_c], axis=-1) @ w_out[l]
            ctx1 = layer_norm(DEEPNORM_ALPHA * ctx + cg1 * yc, ln1_g[l], ln1_b[l])
            fc = conv_ffn(modulate(ctx1, csh2, csc2), w_up[l], w_gate[l], conv_w[l], conv_b[l], w_down[l])
            ctx = layer_norm(DEEPNORM_ALPHA * ctx1 + cg2 * fc, ln2_g[l], ln2_b[l])
    return x
```

```cpp
#include <hip/hip_runtime.h>
#include <cstdio>
#include <cstdint>

#define GAS __attribute__((address_space(1)))
#define LAS __attribute__((address_space(3)))
typedef unsigned short bf16_t;
typedef short bf16x8 __attribute__((ext_vector_type(8)));
typedef short s16x4 __attribute__((ext_vector_type(4)));
typedef float f32x4 __attribute__((ext_vector_type(4)));
typedef float f32x2 __attribute__((ext_vector_type(2)));
typedef float f32x16 __attribute__((ext_vector_type(16)));
typedef unsigned u32x4 __attribute__((ext_vector_type(4)));
typedef unsigned u32x2 __attribute__((ext_vector_type(2)));

constexpr int DM = 2048, NB = 8, SEQ = 4096, DEPTH = 4, CTXL = 256, HD = 128, DFF = 5632;
constexpr int NLAT = NB * SEQ, NCTX = NB * CTXL, NTOK = NLAT + NCTX;
constexpr int KP = 2112;
constexpr int PW = 2560;
constexpr int NMODROW = 9, MODW = 6 * DM;
constexpr float LN_EPS = 1e-6f;
constexpr float DN_ALPHA = 1.681792830507429f;

constexpr size_t MiB = 1u << 20;
constexpr size_t WS_CTL = 0, CTL_ZERO_BYTES = 1 * MiB;
constexpr size_t WS_MOD = 1 * MiB;
constexpr size_t WS_MODP = 3 * MiB;
constexpr size_t WS_ROPE = 17 * MiB;
constexpr size_t WS_DFTC = 17 * MiB + 65536;
constexpr size_t WS_XC = 18 * MiB;
constexpr size_t WS_DFT = 34 * MiB;
constexpr size_t WS_UTF = 66 * MiB;
constexpr size_t WS_C2048 = 17 * MiB + 65536 + 262144;
constexpr size_t WS_W = 98 * MiB;
constexpr size_t WL_IN = 0, WL_F = 11 * MiB, WL_FH = 16 * MiB, WL_OUT = 19 * MiB, WL_GU = 28 * MiB, WL_DN = 74 * MiB, WL_STRIDE = 96 * MiB;
constexpr size_t WS_H = 482 * MiB;
constexpr size_t WS_XH = 623 * MiB;
constexpr size_t WS_Y = 759 * MiB;
constexpr size_t WS_P = 759 * MiB;
constexpr size_t WS_UTC = 929 * MiB;
constexpr size_t WS_UT = 933 * MiB;
constexpr size_t WS_CC = 933 * MiB;
constexpr size_t WS_U = 1074 * MiB;
constexpr size_t WS_YP = 1448 * MiB;
constexpr size_t WS_GEDGE = 1480 * MiB;
constexpr size_t WS_UEDGE = 1492 * MiB;
constexpr size_t WS_END = 1498 * MiB;
static_assert((size_t)NTOK * PW * 2 <= 170 * MiB && (size_t)NTOK * KP * 2 <= 141 * MiB && (size_t)NTOK * DFF * 2 <= 374 * MiB && WS_W + 4 * WL_STRIDE <= WS_H, "ws map");
static_assert((size_t)2560 * KP * 2 <= 11 * MiB && (size_t)1024 * KP * 2 <= 5 * MiB && (size_t)2048 * KP * 2 <= 9 * MiB && (size_t)11264 * KP * 2 <= 46 * MiB && (size_t)512 * KP * 2 <= 3 * MiB, "weight map");
constexpr int CW_TMO = 0, CW_BAR = 4096;

constexpr int LDS_BYTES = 147456;
constexpr int MISC_OFF = 131072 + 320;
constexpr int XL_OFF = 131072 + 1024;
constexpr int NWAVES = 8, NTHR = 512;

__device__ __forceinline__ int otid_w(int wave) { int l; asm volatile("v_mbcnt_lo_u32_b32 %0, -1, 0\n\tv_mbcnt_hi_u32_b32 %0, -1, %0" : "=v"(l)); return wave * 64 + l; }
#define otid() otid_w(wave_s)
#define LDS_WAIT() asm volatile("s_waitcnt lgkmcnt(0)" ::: "memory")
#define VM_WAIT() asm volatile("s_waitcnt vmcnt(0)" ::: "memory")
__device__ __forceinline__ unsigned cvt_pk_bf16(float lo, float hi) { unsigned r; asm volatile("v_cvt_pk_bf16_f32 %0, %1, %2" : "=v"(r) : "v"(lo), "v"(hi)); return r; }
__device__ __forceinline__ float bf_lo(unsigned w) { return __uint_as_float(w << 16); }
__device__ __forceinline__ float bf_hi(unsigned w) { return __uint_as_float(w & 0xffff0000u); }

#define XB_TMO      128
#define XB_XCNT(j)  (256  + 64 * (j))
#define XB_XSUB(j)  (1280 + 64 * (j))
#define XB_XGEN(j)  (2304 + 64 * (j))
#define XB_TOP      3328
#define XB_TOPGEN   3392
#define XCD_BAR_WORDS 3456
#define XB_SPIN_CAP (1u << 18)
__device__ __forceinline__ unsigned xb_ld(unsigned* p)              { return __hip_atomic_load(p, __ATOMIC_RELAXED, __HIP_MEMORY_SCOPE_AGENT); }
__device__ __forceinline__ unsigned xb_add(unsigned* p, unsigned v) { return __hip_atomic_fetch_add(p, v, __ATOMIC_RELAXED, __HIP_MEMORY_SCOPE_AGENT); }
__device__ __forceinline__ unsigned xb_xcc_id() { return (unsigned)__builtin_amdgcn_s_getreg((3 << 11) | 20) & 0xFu; }
#define XB_SPIN(cond, bar) do { unsigned _sp = 0; while (cond) { __builtin_amdgcn_s_sleep(1); \
    if ((++_sp & 255u) == 0u) { if (xb_ld(&(bar)[XB_TMO])) break; if (_sp > XB_SPIN_CAP) { atomicAdd(&(bar)[XB_TMO], 1u); break; } } } } while (0)
struct XcdBarrier { unsigned* bar; unsigned x; volatile LAS unsigned* st; };
__device__ __forceinline__ XcdBarrier xcd_barrier_post(unsigned* bar, volatile LAS unsigned* st) {
    XcdBarrier b; b.bar = bar; b.x = xb_xcc_id(); b.st = st;
    if (threadIdx.x == 0) (void)xb_add(&bar[XB_XCNT(b.x)], 1u);
    return b;
}
__device__ __forceinline__ void xcd_barrier_complete(unsigned* bar, unsigned x, unsigned& nloc, unsigned& nx) {
    const unsigned G = gridDim.x * gridDim.y * gridDim.z;
    unsigned sum, cnt, mine, sp = 0u;
    for (;;) {
        sum = 0u; cnt = 0u; mine = 0u;
#pragma unroll
        for (unsigned j = 0; j < 16; ++j) { const unsigned c = xb_ld(&bar[XB_XCNT(j)]); sum += c; cnt += (c > 0u) ? 1u : 0u; mine = (j == x) ? c : mine; }
        if (sum == G) break;
        __builtin_amdgcn_s_sleep(1);
        if ((++sp & 255u) == 0u) { if (xb_ld(&bar[XB_TMO])) break; if (sp > XB_SPIN_CAP) { atomicAdd(&bar[XB_TMO], 1u); break; } }
    }
    nloc = mine > 0u ? mine : 1u; nx = cnt > 0u ? cnt : 1u;
}
__device__ __forceinline__ void xcd_barrier(const XcdBarrier& b, const bool leader  ) {
    asm volatile("s_waitcnt vmcnt(0)" ::: "memory");
    __syncthreads();
    if (leader) {
        unsigned* bar = b.bar;
        __builtin_amdgcn_s_waitcnt(0);
        unsigned nloc = b.st[0], nx = b.st[1];
        if (nloc == 0u) { xcd_barrier_complete(bar, b.x, nloc, nx); b.st[0] = nloc; b.st[1] = nx; }
        const unsigned old = xb_add(&bar[XB_XSUB(b.x)], 1u);
        const unsigned gen = old / nloc;
        if (old + 1u == (gen + 1u) * nloc) {
            __builtin_amdgcn_fence(__ATOMIC_RELEASE, "agent");
            asm volatile("s_waitcnt vmcnt(0)" ::: "memory");
            const unsigned og = xb_add(&bar[XB_TOP], 1u);
            const unsigned tg = og / nx;
            if (og + 1u == (tg + 1u) * nx) xb_add(&bar[XB_TOPGEN], 1u);
            else XB_SPIN(xb_ld(&bar[XB_TOPGEN]) == tg, bar);
            __builtin_amdgcn_fence(__ATOMIC_ACQUIRE, "agent");
            xb_add(&bar[XB_XGEN(b.x)], 1u);
            asm volatile("s_waitcnt vmcnt(0)" ::: "memory");
        } else {
            XB_SPIN(xb_ld(&bar[XB_XGEN(b.x)]) == gen, bar);
            __builtin_amdgcn_fence(__ATOMIC_ACQUIRE, "agent");
            asm volatile("s_waitcnt vmcnt(0)" ::: "memory");
        }
    }
    __syncthreads();
}

#ifndef WGM_A
#define WGM_A 4
#endif
#ifndef WGM_Z
#define WGM_Z 4
#endif
#ifndef WGM_D
#define WGM_D 4
#endif
#ifndef WGM_F
#define WGM_F 4
#endif
#ifndef WGM_H
#define WGM_H 2
#endif
namespace pg8 {
constexpr int BM = 256, BK = 64, HALF = 128, HTB = HALF * BK * 2, STAGE_BYTES = 8 * HTB, NXCD = 8;
__host__ __device__ __forceinline__ int lds_byte(int r, int c) { const int st = (r >> 4) * 2 + (c >> 5), rr = r & 15, cc = c & 31, ob = rr * 64 + cc * 2; return st * 1024 + (ob ^ (((ob >> 9) & 1) << 5)); }
__host__ __device__ __forceinline__ void stage_rc(int b, int& R, int& C) { const int st = b / 1024, sb = b % 1024, swz = sb ^ (((sb >> 9) & 1) << 5); R = (st >> 1) * 16 + swz / 64; C = (st & 1) * 32 + (swz % 64) / 2; }
__host__ __device__ __forceinline__ int perm32(int rho) { const int n = rho >> 4, i = rho & 15; return 8 * (i >> 2) + 4 * n + (i & 3); }

struct Unit { int pm, pn, kind; };
struct MultiOrder {
    const bf16_t *A0, *B0, *A1, *B1; int nM0, nN0, nM1, nN1, n0, ntot, G, c, K  ; int WGM = 4  ;
    __device__ void init(const bf16_t* a0, const bf16_t* b0, int M0, int N0, const bf16_t* a1, const bf16_t* b1, int M1, int N1, int K_, int G_, int c_) {
        A0 = a0; B0 = b0; nM0 = M0 / BM; nN0 = N0 / BM; A1 = a1; B1 = b1; nM1 = M1 / BM; nN1 = N1 / BM; n0 = nM0 * nN0; ntot = n0 + nM1 * nN1; K = K_; G = G_; c = c_; }
    __device__ __forceinline__ bool next(int i, Unit& u, const char*& pa, const char*& pb) const {
        const long L = (long)i * G + c; if (L >= ntot) return false;
        const int s = (L >= n0) ? 1 : 0; int wgid = s ? (int)L - n0 : (int)L;
        const int nM = s ? nM1 : nM0, nN = s ? nN1 : nN0, nwg = nM * nN;
        { const int q = nwg / NXCD, r = nwg % NXCD, xcd = wgid % NXCD, off = wgid / NXCD; wgid = (xcd < r ? xcd * (q + 1) : r * (q + 1) + (xcd - r) * q) + off; }
        const int nig = WGM * nN, gid = wgid / nig, fm = gid * WGM, gsz = (nM - fm) < WGM ? (nM - fm) : WGM;
        u.pm = fm + ((wgid % nig) % gsz); u.pn = (wgid % nig) / gsz; u.kind = s;
        const size_t tstep = (size_t)BM * K * 2;
        pa = (const char*)(s ? A1 : A0) + (size_t)u.pm * tstep; pb = (const char*)(s ? B1 : B0) + (size_t)u.pn * tstep; return true;
    }
};

struct InOrder {
    const bf16_t *H, *Win, *WFh, *WFf; int G, c;
    static constexpr int N0 = (NTOK / 256) * 10, N1 = 2 * (NLAT / 256), N2 = 4 * (NCTX / 256), NT = N0 + N1 + N2, WGM = WGM_A;
    __device__ __forceinline__ bool next(int i, Unit& u, const char*& pa, const char*& pb) const {
        const int L = i * G + c; if (L >= NT) return false;
        const int s = L < N0 ? 0 : (L < N0 + N1 ? 1 : 2); int wgid = L - (s == 0 ? 0 : (s == 1 ? N0 : N0 + N1));
        const int nM = s == 0 ? NTOK / 256 : (s == 1 ? 2 : 4), nN = s == 0 ? 10 : (s == 1 ? NLAT / 256 : NCTX / 256), nwg = nM * nN;
        { const int q = nwg / NXCD, r = nwg % NXCD, xcd = wgid % NXCD, off = wgid / NXCD; wgid = (xcd < r ? xcd * (q + 1) : r * (q + 1) + (xcd - r) * q) + off; }
        const int nig = WGM * nN, gid = wgid / nig, fm = gid * WGM, gsz = (nM - fm) < WGM ? (nM - fm) : WGM;
        u.pm = fm + ((wgid % nig) % gsz); u.pn = (wgid % nig) / gsz; u.kind = s;
        const size_t tstep = (size_t)BM * KP * 2;
        pa = (const char*)(s == 0 ? H : (s == 1 ? WFh : WFf)) + (size_t)u.pm * tstep;
        pb = (const char*)(s == 0 ? Win : H) + (size_t)(s == 2 ? u.pn + NLAT / 256 : u.pn) * tstep; return true;
    }
};
struct SplitKOrder {
    const bf16_t *A, *B; int ldk, Kx, G, c;
    __device__ __forceinline__ bool next(int i, Unit& u, const char*& pa, const char*& pb) const {
        const int L = i * G + c; if (L >= 256) return false;
        u.kind = L & 3; u.pm = (L >> 2) & 7; u.pn = L >> 5;
        pa = (const char*)A + ((size_t)u.pm * BM * ldk + (size_t)u.kind * Kx) * 2; pb = (const char*)B + ((size_t)u.pn * BM * ldk + (size_t)u.kind * Kx) * 2; return true;
    }
};
template <class Loc> struct EpiStore {
    static constexpr bool PERM = true, PERMA = false;
    Loc loc;
    __device__ __forceinline__ void prefetch(const Unit&, int, int) const {}
    __device__ __forceinline__ void operator()(const f32x4 (&acc)[2][2][4][2], const Unit& u, int wr, int wc, int fr, int fq) const {
#pragma unroll
        for (int bj = 0; bj < 2; ++bj) {
            bf16_t* p; int ld; loc(u, bj, p, ld);
            p += (size_t)(wr * 64 + fr) * ld + wc * 32 + 8 * fq;
#pragma unroll
            for (int ai = 0; ai < 2; ++ai)
#pragma unroll
                for (int m = 0; m < 4; ++m) {
                    const f32x4 v0 = acc[ai][bj][m][0], v1 = acc[ai][bj][m][1];
                    u32x4 w; w.x = cvt_pk_bf16(v0[0], v0[1]); w.y = cvt_pk_bf16(v0[2], v0[3]); w.z = cvt_pk_bf16(v1[0], v1[1]); w.w = cvt_pk_bf16(v1[2], v1[3]);
                    *(u32x4*)(p + (size_t)(ai * HALF + m * 16) * ld) = w; }
        }
    }
};

struct EpiConv {
    static constexpr bool PERM = true, PERMA = true;
    bf16_t* Aout; float* Gedge; float* Uedge; const float* cw; const float* cb; LAS unsigned char* xl;
    __device__ __forceinline__ void prefetch(const Unit& u, int wid, int lane) const {
        if (wid < 2) { const int pi = 2 * wid + (lane >> 5); const float* src = (pi < 3 ? cw + (size_t)pi * DFF : cb) + 128 * u.pn + (lane & 31) * 4;
            __builtin_amdgcn_global_load_lds((const unsigned*)src, (LAS unsigned*)(xl + wid * 1024), 16, 0, 0); }
    }
    __device__ __forceinline__ void operator()(const f32x4 (&acc)[2][2][4][2], const Unit& u, int wr, int wc, int fr, int fq) const {
        const int cbase = wc * 32 + 8 * fq;
        const LAS float* XP = (const LAS float*)xl; LAS float* XG = (LAS float*)(xl + 2048) + 2 * 128;
        f32x4 w0[2], w1[2], w2[2], bb[2];
#pragma unroll
        for (int n = 0; n < 2; ++n) { w0[n] = *(const LAS f32x4*)(XP + 0 * 128 + cbase + 4 * n); w1[n] = *(const LAS f32x4*)(XP + 1 * 128 + cbase + 4 * n); w2[n] = *(const LAS f32x4*)(XP + 2 * 128 + cbase + 4 * n); bb[n] = *(const LAS f32x4*)(XP + 3 * 128 + cbase + 4 * n); }
#pragma unroll
        for (int ai = 0; ai < 2; ++ai) { const int blk = ai * 2 + wr;
            if (fr == 0) {
#pragma unroll
                for (int n = 0; n < 2; ++n) *(LAS f32x4*)(XG + (blk * 2 + 0) * 128 + cbase + 4 * n) = acc[ai][0][0][n]; }
            if (fr == 15) {
#pragma unroll
                for (int n = 0; n < 2; ++n) *(LAS f32x4*)(XG + (blk * 2 + 1) * 128 + cbase + 4 * n) = acc[ai][0][3][n]; } }
        { const size_t gcol = (size_t)u.pn * 128 + cbase;
          if (wr == 0 && fr == 0) { float* ge = Gedge + ((size_t)u.pm * 4) * DFF + gcol; float* ue = Uedge + ((size_t)u.pm * 2 + 0) * DFF + gcol;
#pragma unroll
              for (int n = 0; n < 2; ++n) { *(LAS f32x4*)(XG + (-1 * 2 + 1) * 128 + cbase + 4 * n) = (f32x4){0.f, 0.f, 0.f, 0.f}; *(f32x4*)(ge + 4 * n) = acc[0][0][0][n]; *(f32x4*)(ge + DFF + 4 * n) = acc[0][0][1][n]; *(f32x4*)(ue + 4 * n) = acc[0][1][0][n]; } }
          if (wr == 1 && fr == 15) { float* ge = Gedge + ((size_t)u.pm * 4 + 2) * DFF + gcol; float* ue = Uedge + ((size_t)u.pm * 2 + 1) * DFF + gcol;
#pragma unroll
              for (int n = 0; n < 2; ++n) { *(LAS f32x4*)(XG + (4 * 2 + 0) * 128 + cbase + 4 * n) = (f32x4){0.f, 0.f, 0.f, 0.f}; *(f32x4*)(ge + 4 * n) = acc[1][0][2][n]; *(f32x4*)(ge + DFF + 4 * n) = acc[1][0][3][n]; *(f32x4*)(ue + 4 * n) = acc[1][1][3][n]; } } }
        asm volatile("s_waitcnt lgkmcnt(0)" ::: "memory"); __builtin_amdgcn_s_barrier(); asm volatile("" ::: "memory");
        bf16_t* pout = Aout + ((size_t)u.pm * 256 + wr * 64 + 4 * fr) * DFF + (size_t)u.pn * 128 + cbase;
#pragma unroll
        for (int ai = 0; ai < 2; ++ai) { const int blk = ai * 2 + wr;
            f32x4 res[4][2];
#pragma unroll
            for (int n = 0; n < 2; ++n) {
                const f32x4 bprev = *(const LAS f32x4*)(XG + ((blk - 1) * 2 + 1) * 128 + cbase + 4 * n);
                const f32x4 bnext = *(const LAS f32x4*)(XG + ((blk + 1) * 2 + 0) * 128 + cbase + 4 * n);
                f32x4 gp0, gn3;
#pragma unroll
                for (int j = 0; j < 4; ++j) {
                    gp0[j] = __int_as_float(__builtin_amdgcn_update_dpp(__float_as_int(bprev[j]), __float_as_int(acc[ai][0][3][n][j]), 0x111, 0xf, 0xf, false));
                    gn3[j] = __int_as_float(__builtin_amdgcn_update_dpp(__float_as_int(bnext[j]), __float_as_int(acc[ai][0][0][n][j]), 0x101, 0xf, 0xf, false)); }
#pragma unroll
                for (int m = 0; m < 4; ++m) {
                    const f32x4 gp = m == 0 ? gp0 : acc[ai][0][m == 0 ? 0 : m - 1][n];
                    const f32x4 gn = m == 3 ? gn3 : acc[ai][0][m == 3 ? 3 : m + 1][n];
                    const f32x4 z = bb[n] + w0[n] * gp + w1[n] * acc[ai][0][m][n] + w2[n] * gn;
                    const f32x4 t = z * (-1.4426950408889634f);
                    f32x4 den; den[0] = __builtin_amdgcn_exp2f(t[0]); den[1] = __builtin_amdgcn_exp2f(t[1]); den[2] = __builtin_amdgcn_exp2f(t[2]); den[3] = __builtin_amdgcn_exp2f(t[3]);
                    den = den + 1.0f;
                    f32x4 rc; rc[0] = __builtin_amdgcn_rcpf(den[0]); rc[1] = __builtin_amdgcn_rcpf(den[1]); rc[2] = __builtin_amdgcn_rcpf(den[2]); rc[3] = __builtin_amdgcn_rcpf(den[3]);
                    res[m][n] = (z * rc) * acc[ai][1][m][n]; }
            }
#pragma unroll
            for (int m = 0; m < 4; ++m) { u32x4 w; w.x = cvt_pk_bf16(res[m][0][0], res[m][0][1]); w.y = cvt_pk_bf16(res[m][0][2], res[m][0][3]); w.z = cvt_pk_bf16(res[m][1][0], res[m][1][1]); w.w = cvt_pk_bf16(res[m][1][2], res[m][1][3]);
                *(u32x4*)(pout + (size_t)(ai * HALF + m) * DFF) = w; }
        }
    }
};
struct EpiIn {
    static constexpr bool PERM = true, PERMA = false;
    bf16_t *P, *UT, *UTC; const float *qg, *kg; const f32x2* rope; LAS unsigned char* xl;
    __device__ __forceinline__ void prefetch(const Unit&, int, int) const {}
    __device__ __forceinline__ void operator()(const f32x4 (&acc)[2][2][4][2], const Unit& u, int wr, int wc, int fr, int fq) const {
        if (u.kind != 0) {
            bf16_t* base; int ld;
            if (u.kind == 1) { const int b = u.pn >> 4, n0 = (u.pn & 15) * 256; base = UT + (size_t)(b * 512 + u.pm * 256) * 4096 + n0; ld = 4096; }
            else { const int part = u.pm >> 1, f0 = (u.pm & 1) * 256, b = u.pn; base = UTC + (size_t)(b * 512 + f0) * 512 + part * 256; ld = 512; }
#pragma unroll
            for (int bj = 0; bj < 2; ++bj) { bf16_t* p = base + bj * 128 + (size_t)(wr * 64 + fr) * ld + wc * 32 + 8 * fq;
#pragma unroll
                for (int ai = 0; ai < 2; ++ai)
#pragma unroll
                    for (int m = 0; m < 4; ++m) { const f32x4 v0 = acc[ai][bj][m][0], v1 = acc[ai][bj][m][1];
                        u32x4 w; w.x = cvt_pk_bf16(v0[0], v0[1]); w.y = cvt_pk_bf16(v0[2], v0[3]); w.z = cvt_pk_bf16(v1[0], v1[1]); w.w = cvt_pk_bf16(v1[2], v1[3]);
                        *(u32x4*)(p + (size_t)(ai * HALF + m * 16) * ld) = w; } }
            return;
        }
        const int pn = u.pn;
        const bool isv = (pn == 7 || pn == 9), norm = (pn < 4 || pn == 6), latent = u.pm < NLAT / 256;
        const int lane_ = fq * 16 + fr;
        LAS float* XN = (LAS float*)xl;
        const int qb = 4 * wc + fq, axis = qb >> 3, i0 = 4 * (qb & 7);
        f32x4 ga, gb, RA0, RA1, RA2, RA3, RB0, RB1, RB2, RB3;
        { const float* g = (pn == 6 ? kg : qg) + axis * 64 + i0; ga = *(const f32x4*)g; gb = *(const f32x4*)(g + 32); }
#define EPI_IN_ROPE_LD(K, A, B) do { const int pos = axis ? (16 * (K) + fr) : ((4 * u.pm + 2 * ((K) & 1) + wr) & 63); A = *(const f32x4*)(rope + pos * 32 + i0); B = *(const f32x4*)(rope + pos * 32 + i0 + 2); } while (0)
        EPI_IN_ROPE_LD(0, RA0, RB0); EPI_IN_ROPE_LD(1, RA1, RB1); EPI_IN_ROPE_LD(2, RA2, RB2); EPI_IN_ROPE_LD(3, RA3, RB3);
#undef EPI_IN_ROPE_LD
        float rinv[2][2][4];
        if (norm) {
#pragma unroll
            for (int bj = 0; bj < 2; ++bj)
#pragma unroll
                for (int ai = 0; ai < 2; ++ai)
#pragma unroll
                    for (int m = 0; m < 4; ++m) { const f32x4 a = acc[ai][bj][m][0], b = acc[ai][bj][m][1];
                        float ss = (a[0] * a[0] + a[1] * a[1]) + (a[2] * a[2] + a[3] * a[3]) + (b[0] * b[0] + b[1] * b[1]) + (b[2] * b[2] + b[3] * b[3]);
                        { auto rr = __builtin_amdgcn_permlane16_swap(__float_as_uint(ss), __float_as_uint(ss), false, false); ss = __uint_as_float(rr[0]) + __uint_as_float(rr[1]); }
                        { auto rr = __builtin_amdgcn_permlane32_swap(__float_as_uint(ss), __float_as_uint(ss), false, false); ss = __uint_as_float(rr[0]) + __uint_as_float(rr[1]); }
                        if (fq == 0) XN[(bj * 256 + ai * HALF + wr * 64 + m * 16 + fr) * 4 + wc] = ss; }
            asm volatile("s_waitcnt lgkmcnt(0)" ::: "memory"); __builtin_amdgcn_s_barrier(); asm volatile("" ::: "memory");
#pragma unroll
            for (int bj = 0; bj < 2; ++bj)
#pragma unroll
                for (int ai = 0; ai < 2; ++ai)
#pragma unroll
                    for (int m = 0; m < 4; ++m) { const f32x4 t = *(const LAS f32x4*)(XN + (bj * 256 + ai * HALF + wr * 64 + m * 16 + fr) * 4);
                        rinv[bj][ai][m] = __builtin_amdgcn_rsqf(((t[0] + t[1]) + (t[2] + t[3])) * (1.f / 128.f) + LN_EPS); }
        }
        asm volatile("" :: "v"(ga), "v"(gb), "v"(RA0), "v"(RB0), "v"(RA1), "v"(RB1), "v"(RA2), "v"(RB2), "v"(RA3), "v"(RB3));
#define EPI_IN_STEP(AI, M, SA, SB, MA, MB) do { \
                f32x4 a = acc[AI][bj][M][0], b = acc[AI][bj][M][1]; \
                if (norm) { a = a * rinv[bj][AI][M] * ga; b = b * rinv[bj][AI][M] * gb; } \
                if (!isv && latent) {                                    \
                    const f32x4 cs01 = axis ? MA : SA, cs23 = axis ? MB : SB; \
                    const f32x4 c = (f32x4){cs01[0], cs01[2], cs23[0], cs23[2]}, sn = (f32x4){cs01[1], cs01[3], cs23[1], cs23[3]}; \
                    const f32x4 na = a * c - b * sn, nb = a * sn + b * c; a = na; b = nb; } \
                u32x4 w; w.x = cvt_pk_bf16(a[0], a[1]); w.y = cvt_pk_bf16(a[2], a[3]); w.z = cvt_pk_bf16(b[0], b[1]); w.w = cvt_pk_bf16(b[2], b[3]); \
                *(u32x4*)(p + (size_t)((AI) * HALF + (M) * 16) * PW) = w; } while (0)
#pragma unroll
        for (int bj = 0; bj < 2; ++bj) {
            bf16_t* p = P + (size_t)(u.pm * 256 + wr * 64 + fr) * PW + pn * 256 + bj * 128 + wc * 32 + 8 * fq;
            EPI_IN_STEP(0, 0, RA0, RB0, RA0, RB0); EPI_IN_STEP(0, 1, RA0, RB0, RA1, RB1); EPI_IN_STEP(0, 2, RA0, RB0, RA2, RB2); EPI_IN_STEP(0, 3, RA0, RB0, RA3, RB3);
            EPI_IN_STEP(1, 0, RA1, RB1, RA0, RB0); EPI_IN_STEP(1, 1, RA1, RB1, RA1, RB1); EPI_IN_STEP(1, 2, RA1, RB1, RA2, RB2); EPI_IN_STEP(1, 3, RA1, RB1, RA3, RB3);
        }
#undef EPI_IN_STEP
    }
};
struct EpiZ {
    static constexpr bool PERM = true, PERMA = false;
    bf16_t* CC; const float* C2048;
    __device__ __forceinline__ void prefetch(const Unit&, int, int) const {}
    __device__ __forceinline__ void operator()(const f32x4 (&acc)[2][2][4][2], const Unit& u, int wr, int wc, int fr, int fq) const {
        const float sg = (fr & 1) ? -(1.f / 64.f) : (1.f / 64.f);
        f32x4 cc0[2], cc1[2];
#pragma unroll
        for (int bj = 0; bj < 2; ++bj) { const int col = u.pn * 256 + bj * 128 + wc * 32 + 8 * fq; cc0[bj] = *(const f32x4*)(C2048 + col); cc1[bj] = *(const f32x4*)(C2048 + col + 4); }
#pragma unroll
        for (int bj = 0; bj < 2; ++bj) {
            const f32x4 c0 = cc0[bj] * sg, c1 = cc1[bj] * sg;
            bf16_t* p = CC + (size_t)((u.pn >> 1) * SEQ + u.pm * 256 + wr * 64 + fr) * KP + 1536 + (u.pn & 1) * 256 + bj * 128 + wc * 32 + 8 * fq;
#pragma unroll
            for (int ai = 0; ai < 2; ++ai)
#pragma unroll
                for (int m = 0; m < 4; ++m) {
                    const f32x4 v0 = acc[ai][bj][m][0] + c0, v1 = acc[ai][bj][m][1] + c1;
                    u32x4 w; w.x = cvt_pk_bf16(v0[0], v0[1]); w.y = cvt_pk_bf16(v0[2], v0[3]); w.z = cvt_pk_bf16(v1[0], v1[1]); w.w = cvt_pk_bf16(v1[2], v1[3]);
                    *(u32x4*)(p + (size_t)(ai * HALF + m * 16) * KP) = w; }
        }
    }
};
template <class Epi, class Sched, bool ALIGN_EPI = true, bool SP2 = true>
__device__ __forceinline__ void gemm_phase(LAS unsigned char* lds, const int K  , const int ldk  , const Sched& S, const Epi& E, const int wave_s) {
    const int tid = otid(), wid = __builtin_amdgcn_readfirstlane(tid >> 6), lane = tid & 63, wr = wid >> 2, wc = wid & 3, fr = lane & 15, fq = lane >> 4;
    const int nt = K / BK;
    unsigned voffA[2], voffB[2];
#pragma unroll
    for (int i = 0; i < 2; ++i) { int R, C; stage_rc(tid * 16 + i * 8192, R, C); const int Rb = Epi::PERM ? ((R & ~31) + perm32(R & 31)) : R;
        const int Ra = Epi::PERMA ? ((R & 64) | ((R & 15) << 2) | ((R >> 4) & 3)) : R;
        voffA[i] = (unsigned)(Ra * ldk + C) * 2u; voffB[i] = (unsigned)(Rb * ldk + C) * 2u; }
    const size_t kstep = (size_t)(BK * 2);
    const size_t hstep = (size_t)HALF * ldk * 2;
    const unsigned ldsw = (unsigned)wid * 1024u;
    const int aoff = lds_byte(wr * 64 + fr, fq * 8), boff = lds_byte(wc * 32 + fr, fq * 8);
#define PG8_SA(b, h) (((b) * 2 + (h)) * HTB)
#define PG8_SB(b, h) ((4 + (b) * 2 + (h)) * HTB)
#define PG8_STAGE(bufoff, gbase, voff) do { _Pragma("unroll") for (int _i = 0; _i < 2; ++_i) \
        __builtin_amdgcn_global_load_lds((const unsigned*)((const char*)(gbase) + (voff)[_i]), (LAS unsigned*)(lds + (bufoff) + ldsw + _i * 8192), 16, 0, 0); } while (0)
#define PG8_LDA(dst, b, h) do { _Pragma("unroll") for (int m = 0; m < 4; ++m) _Pragma("unroll") for (int k = 0; k < 2; ++k) dst[m][k] = *(const LAS bf16x8*)(lds + PG8_SA(b, h) + aoff + m * 2048 + k * 1024); } while (0)
#define PG8_LDB(dst, b, h) do { _Pragma("unroll") for (int n = 0; n < 2; ++n) _Pragma("unroll") for (int k = 0; k < 2; ++k) dst[n][k] = *(const LAS bf16x8*)(lds + PG8_SB(b, h) + boff + n * 2048 + k * 1024); } while (0)
#define PG8_MMA(ai, bj, At, Bt) do { __builtin_amdgcn_s_setprio(1); _Pragma("unroll") for (int m = 0; m < 4; ++m) _Pragma("unroll") for (int n = 0; n < 2; ++n) _Pragma("unroll") for (int k = 0; k < 2; ++k) \
        acc[ai][bj][m][n] = __builtin_amdgcn_mfma_f32_16x16x32_bf16(Bt[n][k], At[m][k], acc[ai][bj][m][n], 0, 0, 0); __builtin_amdgcn_s_setprio(0); } while (0)
#define PG8_WAIT_V(n) asm volatile("s_waitcnt vmcnt(" #n ")" ::: "memory")
#define PG8_WAIT_L(n) asm volatile("s_waitcnt lgkmcnt(" #n ")" ::: "memory")
#define PG8_BAR __builtin_amdgcn_s_barrier()
#define PG8_SCHED __builtin_amdgcn_sched_barrier(0)
    Unit cur, nxt; int ui = 0;
    const char *cA, *cB, *nA, *nB;
    if (!S.next(0, cur, cA, cB)) return;
    f32x4 acc[2][2][4][2];
#pragma unroll
    for (int a = 0; a < 2; ++a)
#pragma unroll
        for (int b = 0; b < 2; ++b)
#pragma unroll
            for (int m = 0; m < 4; ++m)
#pragma unroll
                for (int n = 0; n < 2; ++n) acc[a][b][m][n] = (f32x4){0.f, 0.f, 0.f, 0.f};
    bf16x8 At[4][2], B0[2][2], B1[2][2];
    if constexpr (SP2) {
        PG8_STAGE(PG8_SB(0, 0), cB, voffB); PG8_STAGE(PG8_SB(0, 1), cB + hstep, voffB); PG8_STAGE(PG8_SA(0, 0), cA, voffA); PG8_STAGE(PG8_SA(0, 1), cA + hstep, voffA);
        if (wr == 1) PG8_BAR;
        PG8_WAIT_V(2); PG8_BAR;
        PG8_STAGE(PG8_SB(1, 0), cB + kstep, voffB); PG8_STAGE(PG8_SA(1, 0), cA + kstep, voffA); PG8_STAGE(PG8_SB(1, 1), cB + hstep + kstep, voffB);
        PG8_WAIT_V(6); PG8_BAR;
    } else {
        PG8_STAGE(PG8_SB(0, 0), cB, voffB); PG8_STAGE(PG8_SA(0, 0), cA, voffA); PG8_STAGE(PG8_SB(0, 1), cB + hstep, voffB); PG8_STAGE(PG8_SA(0, 1), cA + hstep, voffA);
        if (wr == 1) PG8_BAR;
        PG8_WAIT_V(4); PG8_BAR;
        PG8_STAGE(PG8_SB(1, 0), cB + kstep, voffB); PG8_STAGE(PG8_SA(1, 0), cA + kstep, voffA); PG8_STAGE(PG8_SB(1, 1), cB + hstep + kstep, voffB);
        PG8_WAIT_V(6); PG8_BAR;
    }
    for (;;) {
        const bool has_next = S.next(ui + 1, nxt, nA, nB);
        if (!has_next) { nA = cA; nB = cB; }
        for (int t = 0; t < nt; t += 2) {
            const bool last = (t == nt - 2);
            const char* a1 = cA + (size_t)(t + 1) * kstep;
            const char* a2 = last ? nA : cA + (size_t)(t + 2) * kstep; const char* b2 = last ? nB : cB + (size_t)(t + 2) * kstep;
            const char* a3 = a2 + kstep; const char* b3 = b2 + kstep;
            if constexpr (SP2) {
            PG8_LDB(B0, 0, 0); PG8_LDB(B1, 0, 1); PG8_SCHED; PG8_LDA(At, 0, 0); PG8_STAGE(PG8_SA(1, 1), a1 + hstep, voffA);
            if (last) E.prefetch(cur, wid, lane);
            PG8_WAIT_V(8); PG8_WAIT_L(0); PG8_BAR; PG8_MMA(0, 0, At, B0); PG8_MMA(0, 1, At, B1); PG8_BAR; PG8_SCHED;
            PG8_LDA(At, 0, 1); PG8_STAGE(PG8_SB(0, 0), b2, voffB); PG8_STAGE(PG8_SB(0, 1), b2 + hstep, voffB); PG8_STAGE(PG8_SA(0, 0), a2, voffA);
            PG8_WAIT_V(8); PG8_WAIT_L(0); PG8_BAR; PG8_MMA(1, 0, At, B0); PG8_MMA(1, 1, At, B1); PG8_BAR; PG8_SCHED;
            PG8_LDB(B0, 1, 0); PG8_LDB(B1, 1, 1); PG8_SCHED; PG8_LDA(At, 1, 0); PG8_STAGE(PG8_SA(0, 1), a2 + hstep, voffA);
            PG8_WAIT_V(8); PG8_WAIT_L(0); PG8_BAR; PG8_MMA(0, 0, At, B0); PG8_MMA(0, 1, At, B1); PG8_BAR; PG8_SCHED;
            PG8_LDA(At, 1, 1); PG8_STAGE(PG8_SB(1, 0), b3, voffB); PG8_STAGE(PG8_SB(1, 1), b3 + hstep, voffB); PG8_STAGE(PG8_SA(1, 0), a3, voffA);
            PG8_WAIT_V(8); PG8_WAIT_L(0); PG8_BAR; PG8_MMA(1, 0, At, B0); PG8_MMA(1, 1, At, B1); PG8_BAR; PG8_SCHED;
            } else {
            PG8_LDB(B0, 0, 0); PG8_SCHED; PG8_LDA(At, 0, 0); PG8_STAGE(PG8_SA(1, 1), a1 + hstep, voffA);
            PG8_WAIT_L(8); PG8_BAR; PG8_WAIT_L(0); PG8_MMA(0, 0, At, B0); PG8_BAR; PG8_SCHED;
            PG8_LDB(B1, 0, 1); PG8_STAGE(PG8_SB(0, 0), b2, voffB);
            PG8_BAR; PG8_WAIT_L(0); PG8_MMA(0, 1, At, B1); PG8_BAR;
            PG8_LDA(At, 0, 1); PG8_STAGE(PG8_SA(0, 0), a2, voffA);
            PG8_BAR; PG8_WAIT_L(0); PG8_MMA(1, 0, At, B0); PG8_BAR; PG8_SCHED;
            PG8_STAGE(PG8_SB(0, 1), b2 + hstep, voffB);
            PG8_WAIT_V(6); PG8_BAR; PG8_MMA(1, 1, At, B1); PG8_BAR;
            PG8_LDB(B0, 1, 0); PG8_SCHED; PG8_LDA(At, 1, 0); PG8_STAGE(PG8_SA(0, 1), a2 + hstep, voffA);
            PG8_WAIT_L(8); PG8_BAR; PG8_WAIT_L(0); PG8_MMA(0, 0, At, B0); PG8_BAR; PG8_SCHED;
            PG8_LDB(B1, 1, 1); PG8_STAGE(PG8_SB(1, 0), b3, voffB);
            PG8_BAR; PG8_WAIT_L(0); PG8_MMA(0, 1, At, B1); PG8_BAR;
            PG8_LDA(At, 1, 1); PG8_STAGE(PG8_SA(1, 0), a3, voffA);
            PG8_BAR; PG8_WAIT_L(0); PG8_MMA(1, 0, At, B0); PG8_BAR; PG8_SCHED;
            PG8_STAGE(PG8_SB(1, 1), b3 + hstep, voffB);
            PG8_WAIT_V(6); PG8_BAR; PG8_MMA(1, 1, At, B1); PG8_BAR;
            }
        }
        if constexpr (ALIGN_EPI) { if (wr == 0) PG8_BAR; }
        E(acc, cur, wr, wc, fr, fq);
        if (!has_next) break;
#pragma unroll
        for (int a = 0; a < 2; ++a)
#pragma unroll
            for (int b = 0; b < 2; ++b)
#pragma unroll
                for (int m = 0; m < 4; ++m)
#pragma unroll
                    for (int n = 0; n < 2; ++n) acc[a][b][m][n] = (f32x4){0.f, 0.f, 0.f, 0.f};
        cur = nxt; cA = nA; cB = nB; ++ui;
        if constexpr (ALIGN_EPI) { if (wr == 1) PG8_BAR; }
    }
    PG8_WAIT_V(0);
    if constexpr (!ALIGN_EPI) { if (wr == 0) PG8_BAR; }
    PG8_BAR;
#undef PG8_SA
#undef PG8_SB
#undef PG8_STAGE
#undef PG8_LDA
#undef PG8_LDB
#undef PG8_MMA
#undef PG8_WAIT_V
#undef PG8_WAIT_L
#undef PG8_BAR
#undef PG8_SCHED
}
}

namespace att {
constexpr int NW = 8, QBLK = 32, KVBLK = 64;
constexpr float SCALE = 0.088388347648318440f;
constexpr float THR = 8.f;
constexpr int SHM_V = KVBLK * HD * 2, SHM_K = KVBLK * HD * 2, SHM_ATTN = 3 * SHM_V + 3 * SHM_K + NW * 64 * 4;
#define KSWZ(row, colB) ((row) * 256 + ((colB) ^ (((row) & 7) << 4)))
#define SBAR() __builtin_amdgcn_sched_barrier(0)
__device__ __forceinline__ int crow(int r, int hi) { return (r & 3) + 8 * (r >> 2) + 4 * hi; }
__device__ __forceinline__ void partialSM(f32x16& p0, f32x16& p1, float& m_reg, float& mn, float& alpha) {
  constexpr float C = SCALE * 1.4426950408889634f;
  float pmax = p0[0];
#pragma unroll
  for (int r = 1; r < 16; ++r) pmax = fmaxf(pmax, p0[r]);
#pragma unroll
  for (int r = 0; r < 16; ++r) pmax = fmaxf(pmax, p1[r]);
  { auto rr = __builtin_amdgcn_permlane32_swap(__float_as_uint(pmax), __float_as_uint(pmax), false, false);
    pmax = fmaxf(__uint_as_float(rr[0]), __uint_as_float(rr[1])); }
  if (__builtin_expect(__all(pmax - m_reg <= THR / SCALE), 1)) { mn = m_reg; alpha = 1.f; }
  else { mn = fmaxf(m_reg, pmax); alpha = __builtin_amdgcn_exp2f((m_reg - mn) * C); m_reg = mn; }
  float mnC = -mn * C;
#pragma unroll
  for (int r = 0; r < 16; ++r) p0[r] = fmaf(p0[r], C, mnC);
#pragma unroll
  for (int r = 0; r < 16; ++r) p1[r] = fmaf(p1[r], C, mnC);
#pragma unroll
  for (int r = 0; r < 16; ++r) p0[r] = __builtin_amdgcn_exp2f(p0[r]);
}
__device__ __forceinline__ void finishSM(f32x16& p0, f32x16& p1, float alpha, float& l_reg, bf16x8& pa0, bf16x8& pa1, bf16x8& pa2, bf16x8& pa3) {
#pragma unroll
  for (int r = 0; r < 16; ++r) p1[r] = __builtin_amdgcn_exp2f(p1[r]);
  float ps = 0;
#pragma unroll
  for (int r = 0; r < 16; ++r) ps += p0[r];
#pragma unroll
  for (int r = 0; r < 16; ++r) ps += p1[r];
  { auto rr = __builtin_amdgcn_permlane32_swap(__float_as_uint(ps), __float_as_uint(ps), false, false);
    ps = __uint_as_float(rr[0]) + __uint_as_float(rr[1]); }
  l_reg = l_reg * alpha + ps;
#define PK4(P, BASE, OUT) do { unsigned a0 = cvt_pk_bf16(P[BASE + 0], P[BASE + 1]), a1 = cvt_pk_bf16(P[BASE + 2], P[BASE + 3]);   \
    unsigned b0 = cvt_pk_bf16(P[BASE + 4], P[BASE + 5]), b1 = cvt_pk_bf16(P[BASE + 6], P[BASE + 7]);                              \
    auto r0 = __builtin_amdgcn_permlane32_swap(a0, b0, false, false); auto r1 = __builtin_amdgcn_permlane32_swap(a1, b1, false, false); \
    u32x4 w = {r0[0], r1[0], r0[1], r1[1]}; OUT = *reinterpret_cast<bf16x8*>(&w); } while (0)
  PK4(p0, 0, pa0); PK4(p0, 8, pa1); PK4(p1, 0, pa2); PK4(p1, 8, pa3);
#undef PK4
}
__device__ __forceinline__ void qkt(f32x16& p0, f32x16& p1, const char* Ks, const bf16x8* qr, int r32, int hi) {
  p0 = f32x16{}; p1 = f32x16{};
#pragma unroll
  for (int d0 = 0; d0 < 8; ++d0) { int cb = (d0 * 16 + hi * 8) * 2;
    bf16x8 b0 = *reinterpret_cast<const bf16x8*>(Ks + KSWZ(r32, cb));
    bf16x8 b1 = *reinterpret_cast<const bf16x8*>(Ks + KSWZ(32 + r32, cb));
    p0 = __builtin_amdgcn_mfma_f32_32x32x16_bf16(b0, qr[d0], p0, 0, 0, 0);
    p1 = __builtin_amdgcn_mfma_f32_32x32x16_bf16(b1, qr[d0], p1, 0, 0, 0); }
}
__device__ __forceinline__ void wmask(f32x16& p0, f32x16& p1, int relbase, int hi) {
#pragma unroll
  for (int r = 0; r < 16; ++r) { const int ko = (r & 3) + 8 * (r >> 2); const int d0 = relbase - ko, d1 = d0 - 32;
    if (d0 > 128 || d0 < -128) p0[r] = -1e30f; if (d1 > 128 || d1 < -128) p1[r] = -1e30f; }
}
__device__ __forceinline__ int v_st(int k, int c) { const int kk = (k & ~0xC) | ((k & 4) << 1) | ((k & 8) >> 1); return ((kk >> 3) * 4 + (c >> 5)) * 512 + ((kk & 7) * 32 + (c & 31)) * 2; }
__device__ __forceinline__ int v_rd_base(int lane) { return ((lane & 3) << 3) | (((lane >> 2) & 3) << 6) | (((lane >> 4) & 1) << 5) | (((lane >> 5) & 1) << 8); }
constexpr int v_rd_off(int d0, int ks, int half) { return d0 * 512 + ks * 4096 + half * 2048; }
template <int OFF> __device__ __forceinline__ s16x4 tr_read(int vb) {
  return __builtin_amdgcn_ds_read_tr16_b64_v4i16((LAS s16x4*)(uintptr_t)(unsigned)(vb + OFF));
}
template <int D0> __device__ __forceinline__ void pv_one(f32x16& od, int vb, bf16x8 pa0, bf16x8 pa1, bf16x8 pa2, bf16x8 pa3) {
  const s16x4 l0 = tr_read<v_rd_off(D0, 0, 0)>(vb), h0 = tr_read<v_rd_off(D0, 0, 1)>(vb), l1 = tr_read<v_rd_off(D0, 1, 0)>(vb), h1 = tr_read<v_rd_off(D0, 1, 1)>(vb);
  const s16x4 l2 = tr_read<v_rd_off(D0, 2, 0)>(vb), h2 = tr_read<v_rd_off(D0, 2, 1)>(vb), l3 = tr_read<v_rd_off(D0, 3, 0)>(vb), h3 = tr_read<v_rd_off(D0, 3, 1)>(vb);
#define PK(L, H) (bf16x8){L[0], L[1], L[2], L[3], H[0], H[1], H[2], H[3]}
  od = __builtin_amdgcn_mfma_f32_32x32x16_bf16(pa0, PK(l0, h0), od, 0, 0, 0);
  od = __builtin_amdgcn_mfma_f32_32x32x16_bf16(pa1, PK(l1, h1), od, 0, 0, 0);
  od = __builtin_amdgcn_mfma_f32_32x32x16_bf16(pa2, PK(l2, h2), od, 0, 0, 0);
  od = __builtin_amdgcn_mfma_f32_32x32x16_bf16(pa3, PK(l3, h3), od, 0, 0, 0);
#undef PK
}
__device__ __forceinline__ void pv_d0(f32x16* o, int vb, bf16x8 pa0, bf16x8 pa1, bf16x8 pa2, bf16x8 pa3) {
  pv_one<0>(o[0], vb, pa0, pa1, pa2, pa3); pv_one<1>(o[1], vb, pa0, pa1, pa2, pa3); pv_one<2>(o[2], vb, pa0, pa1, pa2, pa3); pv_one<3>(o[3], vb, pa0, pa1, pa2, pa3);
}

struct AUnit {
  const bf16_t* q;
  const bf16_t *k0; int n0;
  const bf16_t *k1;
  bf16_t* o;
  int win, qk_off;
  float m0, l0;
};
template <bool WIN>
__device__ __forceinline__ void attn_unit(const AUnit& U, char* lds, const int wave_s) {
  const int tid = otid();
  const int wid = tid >> 6, lane = tid & 63, r32 = lane & 31, hi = lane >> 5;
  char* V_lds = lds; char* K_lds = lds + 3 * SHM_V;
  float* ws = (float*)(lds + 3 * SHM_V + 3 * SHM_K) + wid * 64; float* li_l = ws; float* al_l = ws + 32;
  float m_reg = U.m0, l_reg = U.l0; f32x16 o[4] = {}; bf16x8 qr[8];
  const bf16_t* Qw = U.q + (long)(wid * QBLK + r32) * PW + hi * 8;
#pragma unroll
  for (int d0 = 0; d0 < 8; ++d0) qr[d0] = *reinterpret_cast<const bf16x8*>(Qw + d0 * 16);
  const int sr = tid >> 4, sc = (tid & 15) * 8, vst0 = v_st(sr, sc), vst1 = v_st(32 + sr, sc);
  const int vb0 = (int)(uintptr_t)V_lds + v_rd_base(lane);
  const int n0 = U.n0, NT = U.n0 + CTXL / 64;
  struct { bf16x8 vs0, vs1, ks0, ks1; } sr_[2];
#define TILE_K(t) ((t) < n0 ? U.k0 + (long)(t) * (KVBLK * PW) : U.k1 + (long)((t) - n0) * (KVBLK * PW))
#define SLOAD(i, t) do { const bf16_t* kp_ = TILE_K(t); const bf16_t* vp_ = kp_ + 256; \
    sr_[i].vs0 = *reinterpret_cast<const bf16x8*>(vp_ + (long)sr * PW + sc); sr_[i].vs1 = *reinterpret_cast<const bf16x8*>(vp_ + (long)(32 + sr) * PW + sc); \
    sr_[i].ks0 = *reinterpret_cast<const bf16x8*>(kp_ + (long)sr * PW + sc); sr_[i].ks1 = *reinterpret_cast<const bf16x8*>(kp_ + (long)(32 + sr) * PW + sc); } while (0)
#define SWRITE(bo, i) do { *(bf16x8*)(V_lds + (bo) + vst0) = sr_[i].vs0; *(bf16x8*)(V_lds + (bo) + vst1) = sr_[i].vs1; int kc = sc * 2; \
    *(bf16x8*)(K_lds + (bo) + KSWZ(sr, kc)) = sr_[i].ks0; *(bf16x8*)(K_lds + (bo) + KSWZ(32 + sr, kc)) = sr_[i].ks1; } while (0)
#define SWAIT() asm volatile("s_waitcnt vmcnt(4)" ::: "memory")
#define RESC(a) do { if (__any((a) < 1.f)) { if (hi == 0) al_l[r32] = (a); asm volatile("s_waitcnt lgkmcnt(0)" ::: "memory"); \
    _Pragma("unroll") for (int d = 0; d < 4; ++d) _Pragma("unroll") for (int r = 0; r < 16; ++r) o[d][r] *= al_l[crow(r, hi)]; } } while (0)
#define WMASK(P0, P1, t) do { if (WIN && (t) < n0) wmask(P0, P1, wid * QBLK + r32 + U.qk_off - (t) * KVBLK - 4 * hi, hi); } while (0)
  f32x16 pA0, pA1, pB0, pB1; float mnA, mnB, alA, alB; bf16x8 pa0, pa1, pa2, pa3;
  constexpr int SE = 0, SO = 1;
  static_assert(SHM_V == SHM_K, "one ring offset for both");
  SLOAD(SE, 0); asm volatile("s_waitcnt vmcnt(0)" ::: "memory"); SWRITE(0, SE); __syncthreads();
  qkt(pA0, pA1, K_lds, qr, r32, hi); WMASK(pA0, pA1, 0); partialSM(pA0, pA1, m_reg, mnA, alA);
  SLOAD(SO, 1); if (2 < NT) SLOAD(SE, 2);
  SWAIT(); SWRITE(SHM_K, SO); __syncthreads();
  int rp = 0, rc = SHM_K, rn = 2 * SHM_K;
#pragma unroll 1
  for (int j = 1; j + 1 < NT; j += 2) {
    SBAR(); qkt(pB0, pB1, K_lds + rc, qr, r32, hi);
    finishSM(pA0, pA1, alA, l_reg, pa0, pa1, pa2, pa3); SBAR();
    SLOAD(SO, j + 2); SBAR();
    pv_d0(o, vb0 + rp, pa0, pa1, pa2, pa3); WMASK(pB0, pB1, j); partialSM(pB0, pB1, m_reg, mnB, alB);
    SWAIT(); SWRITE(rn, SE);
    RESC(alB); __syncthreads();
    SBAR(); qkt(pA0, pA1, K_lds + rn, qr, r32, hi);
    finishSM(pB0, pB1, alB, l_reg, pa0, pa1, pa2, pa3); SBAR();
    if (j + 3 < NT) SLOAD(SE, j + 3); SBAR();
    pv_d0(o, vb0 + rc, pa0, pa1, pa2, pa3); WMASK(pA0, pA1, j + 1); partialSM(pA0, pA1, m_reg, mnA, alA);
    SWAIT(); SWRITE(rp, SO);
    RESC(alA); __syncthreads();
    { const int t = rp; rp = rn; rn = rc; rc = t; }
  }
  SBAR(); qkt(pB0, pB1, K_lds + rc, qr, r32, hi);
  finishSM(pA0, pA1, alA, l_reg, pa0, pa1, pa2, pa3); SBAR();
  pv_d0(o, vb0 + rp, pa0, pa1, pa2, pa3); WMASK(pB0, pB1, NT - 1); partialSM(pB0, pB1, m_reg, mnB, alB);
  RESC(alB);
  finishSM(pB0, pB1, alB, l_reg, pa0, pa1, pa2, pa3); SBAR();
  pv_d0(o, vb0 + rc, pa0, pa1, pa2, pa3);
  if (hi == 0) li_l[r32] = l_reg; asm volatile("s_waitcnt lgkmcnt(0)" ::: "memory");
  float rli[16];
#pragma unroll
  for (int r = 0; r < 16; ++r) rli[r] = __builtin_amdgcn_rcpf(li_l[crow(r, hi)]);
  bf16_t* Ow = U.o + (long)(wid * QBLK) * KP;
#pragma unroll
  for (int r = 0; r < 16; ++r) { const int orow = crow(r, hi);
#pragma unroll
    for (int d0 = 0; d0 < 4; ++d0) Ow[(long)orow * KP + d0 * 32 + r32] = (bf16_t)(cvt_pk_bf16(o[d0][r] * rli[r], 0.f) & 0xffffu); }
  __syncthreads();
#undef TILE_K
#undef SLOAD
#undef SWRITE
#undef SWAIT
#undef RESC
#undef WMASK
}
}

struct Args { const float* in[21]; float* out; unsigned char* ws; };

__device__ __forceinline__ unsigned long long karg_u64(int byte_off) {
    auto ka = __builtin_amdgcn_kernarg_segment_ptr();
    unsigned long long v; asm volatile("s_load_dwordx2 %0, %1, %2\n\ts_waitcnt lgkmcnt(0)" : "=s"(v) : "s"(ka), "i"(byte_off) : "memory"); return v; }
#define ARG_IN(i) ((const float*)(const GAS float*)karg_u64((i) * 8))
#define ARG_OUT ((float*)(GAS float*)karg_u64(21 * 8))
#define ARG_WS ((unsigned char*)(GAS unsigned char*)karg_u64(22 * 8))
enum { I_X = 0, I_C, I_CTX, I_CCTX, I_WMOD, I_BMOD, I_WIN, I_QG, I_KG, I_SINK, I_WF, I_WOUT, I_LN1G, I_LN1B, I_WUP, I_WGATE, I_CONVW, I_CONVB, I_WDOWN, I_LN2G, I_LN2B };

__device__ __forceinline__ float shfl_xor_l(float v, int o, int lane) { return __int_as_float(__builtin_amdgcn_ds_bpermute((lane ^ o) << 2, __float_as_int(v))); }
__device__ __forceinline__ float wave_sum(float v, int lane) {
    (void)lane;
    v += __int_as_float(__builtin_amdgcn_update_dpp(0, __float_as_int(v), 0xB1, 0xf, 0xf, false));
    v += __int_as_float(__builtin_amdgcn_update_dpp(0, __float_as_int(v), 0x4E, 0xf, 0xf, false));
    v += __int_as_float(__builtin_amdgcn_update_dpp(0, __float_as_int(v), 0x141, 0xf, 0xf, false));
    v += __int_as_float(__builtin_amdgcn_update_dpp(0, __float_as_int(v), 0x140, 0xf, 0xf, false));
    { auto rr = __builtin_amdgcn_permlane16_swap(__float_as_uint(v), __float_as_uint(v), false, false); v = __uint_as_float(rr[0]) + __uint_as_float(rr[1]); }
    { auto rr = __builtin_amdgcn_permlane32_swap(__float_as_uint(v), __float_as_uint(v), false, false); v = __uint_as_float(rr[0]) + __uint_as_float(rr[1]); }
    return v;
}
__device__ __forceinline__ float silu_f(float v) { return v * __builtin_amdgcn_rcpf(1.f + __expf(-v)); }

__device__ __forceinline__ void p0_mod(const float* c, const float* c_ctx, const float* w_mod, float* modp, LAS float* sl, int gw, int NGW, int tid, int lane) {
    for (int i = tid; i < NMODROW * DM; i += NTHR) { const float v = i < NB * DM ? c[i] : c_ctx[i - NB * DM]; sl[i] = v / (1.f + expf(-v)); }
    __syncthreads();
    for (int item = gw; item < DEPTH * 48 * 8; item += NGW) {
        const int l = item / 384, rem = item % 384, cc = rem >> 3, ks = rem & 7;
        const float* W = w_mod + ((size_t)l * DM + ks * 256) * MODW + cc * 256 + lane * 4;
        f32x4 acc[NMODROW];
#pragma unroll
        for (int j = 0; j < NMODROW; ++j) acc[j] = (f32x4){0.f, 0.f, 0.f, 0.f};
#pragma unroll 8
        for (int k = 0; k < 256; ++k) {
            const f32x4 w = *(const f32x4*)(W + (size_t)k * MODW);
#pragma unroll
            for (int j = 0; j < NMODROW; ++j) acc[j] += sl[j * DM + ks * 256 + k] * w;
        }
#pragma unroll
        for (int j = 0; j < NMODROW; ++j) *(f32x4*)(modp + ((size_t)((ks * DEPTH + l) * NMODROW + j)) * MODW + cc * 256 + lane * 4) = acc[j];
    }
    __syncthreads();
}
__device__ __forceinline__ void transpose_item(const float* W, size_t ldw, bf16_t* WT, size_t ldt, LAS float* scr, int lane, int lanecol  ) {
    float t_[32];
#pragma unroll
    for (int i = 0; i < 32; ++i) t_[i] = W[(size_t)(2 * i + (lane >> 5)) * ldw + lanecol];
#pragma unroll
    for (int i = 0; i < 32; ++i) scr[(2 * i + (lane >> 5)) * 33 + (lane & 31)] = t_[i];
    LDS_WAIT(); asm volatile("" ::: "memory");
    const int c = lane & 7;
#pragma unroll
    for (int j = 0; j < 4; ++j) { const int n = (lane >> 3) + 8 * j; const LAS float* s = scr + (8 * c) * 33 + n;
        u32x4 o; o.x = cvt_pk_bf16(s[0 * 33], s[1 * 33]); o.y = cvt_pk_bf16(s[2 * 33], s[3 * 33]); o.z = cvt_pk_bf16(s[4 * 33], s[5 * 33]); o.w = cvt_pk_bf16(s[6 * 33], s[7 * 33]);
        *(u32x4*)(WT + (size_t)n * ldt + 8 * c) = o; }
    LDS_WAIT(); asm volatile("" ::: "memory");
}
__host__ __device__ __forceinline__ int hperm(int p) { const int qb = p >> 3, e = p & 7; return (qb >> 3) * 64 + (e >> 2) * 32 + 4 * (qb & 7) + (e & 3); }
constexpr int TI_IN = 32 * 80, TI_OUT = 24 * 64, TI_G = 32 * 176, TI_D = 88 * 64, TI_LAYER = TI_IN + TI_OUT + 2 * TI_G + TI_D;
__device__ __forceinline__ void p0_transposes(LAS float* scr, int gw, int NGW, int lane) {
    for (int it0 = gw; it0 < DEPTH * TI_LAYER; it0 += NGW) {
        const int l = it0 / TI_LAYER; int it = it0 % TI_LAYER;
        unsigned char* wl = ARG_WS + WS_W + (size_t)l * WL_STRIDE;
        if (it < TI_IN) { const int kb = it / 80, nb = it % 80;
            const int n0 = 32 * nb, hb = n0 & ~127; const bool isqk = n0 < 1792 || (n0 >= 2048 && n0 < 2304);
            transpose_item(ARG_IN(I_WIN) + (size_t)l * DM * 3072 + (size_t)(64 * kb) * 3072, 3072, (bf16_t*)(wl + WL_IN) + (size_t)n0 * KP + 64 * kb, KP, scr, lane, isqk ? hb + hperm(n0 - hb + (lane & 31)) : n0 + (lane & 31)); continue; }
        it -= TI_IN;
        if (it < TI_OUT) { const int kb = it / 64, nb = it % 64;
            transpose_item(ARG_IN(I_WOUT) + (size_t)l * DM * DM + (size_t)(64 * kb) * DM + 32 * nb, DM, (bf16_t*)(wl + WL_OUT) + (size_t)(32 * nb) * KP + 64 * kb, KP, scr, lane, lane & 31); continue; }
        it -= TI_OUT;
        if (it < 2 * TI_G) { const int up = it >= TI_G; if (up) it -= TI_G; const int kb = it / 176, nb = it % 176, n0 = 32 * nb, drow = 256 * (n0 >> 7) + (n0 & 127) + (up ? 128 : 0);
            transpose_item((up ? ARG_IN(I_WUP) : ARG_IN(I_WGATE)) + (size_t)l * DM * DFF + (size_t)(64 * kb) * DFF + n0, DFF, (bf16_t*)(wl + WL_GU) + (size_t)drow * KP + 64 * kb, KP, scr, lane, lane & 31); continue; }
        it -= 2 * TI_G;
        { const int kb = it / 64, nb = it % 64;
            transpose_item(ARG_IN(I_WDOWN) + (size_t)l * DFF * DM + (size_t)(64 * kb) * DM + 32 * nb, DM, (bf16_t*)(wl + WL_DN) + (size_t)(32 * nb) * DFF + 64 * kb, DFF, scr, lane, lane & 31); }
    }
}
__device__ __forceinline__ void split8(const f32x4 a, const f32x4 b, bf16x8& hi, bf16x8& lo) {
    u32x4 h, r;
    h.x = cvt_pk_bf16(a[0], a[1]); h.y = cvt_pk_bf16(a[2], a[3]); h.z = cvt_pk_bf16(b[0], b[1]); h.w = cvt_pk_bf16(b[2], b[3]);
    r.x = cvt_pk_bf16(a[0] - bf_lo(h.x), a[1] - bf_hi(h.x)); r.y = cvt_pk_bf16(a[2] - bf_lo(h.y), a[3] - bf_hi(h.y));
    r.z = cvt_pk_bf16(b[0] - bf_lo(h.z), b[1] - bf_hi(h.z)); r.w = cvt_pk_bf16(b[2] - bf_lo(h.w), b[3] - bf_hi(h.w));
    hi = __builtin_bit_cast(bf16x8, h); lo = __builtin_bit_cast(bf16x8, r);
}
#define MFMA3(acc, Ah, Al, Bh, Bl) do { acc = __builtin_amdgcn_mfma_f32_16x16x32_bf16(Ah, Bh, acc, 0, 0, 0); acc = __builtin_amdgcn_mfma_f32_16x16x32_bf16(Ah, Bl, acc, 0, 0, 0); \
    acc = __builtin_amdgcn_mfma_f32_16x16x32_bf16(Al, Bh, acc, 0, 0, 0); } while (0)
__device__ __forceinline__ void p0_fold_f(int c, int G, int tid) {
    const int wid = tid >> 6, lane = tid & 63, fr = lane & 15, fq = lane >> 4;
    const int slot = wid * 16 + fr, part = slot > 64 ? 1 : 0, f = part ? slot - 64 : slot;
    bf16x8 Th[4], Tl[4];
#pragma unroll
    for (int kk = 0; kk < 4; ++kk) { float t[8];
#pragma unroll
        for (int j = 0; j < 8; ++j) { const int cc = kk * 32 + fq * 8 + j; const float x = (float)((f * cc) & 127) * (1.f / 128.f);
            t[j] = part ? __builtin_amdgcn_sinf(x) : __builtin_amdgcn_cosf(x); }
        split8((f32x4){t[0], t[1], t[2], t[3]}, (f32x4){t[4], t[5], t[6], t[7]}, Th[kk], Tl[kk]); }
    const bool mir = (f != 0 && f != 64);
    for (int item = c; item < DEPTH * 4 * 32; item += G) {
        const int l = item >> 7, g = (item >> 5) & 3, dc = item & 31;
        const float* src = ARG_IN(I_WIN) + (size_t)l * DM * 3072 + (size_t)(dc * 64 + fr) * 3072 + 2560 + g * 128 + fq * 8;
        bf16_t* dstf = (bf16_t*)(ARG_WS + WS_W + (size_t)l * WL_STRIDE + WL_F) + dc * 64 + fq * 4;
        bf16_t* dsth = (bf16_t*)(ARG_WS + WS_W + (size_t)l * WL_STRIDE + WL_FH) + (size_t)(g * 128 + slot) * KP + dc * 64 + fq * 4;
        const size_t row0 = (size_t)(part * 512 + g * 128 + f) * KP, row1 = mir ? (size_t)(part * 512 + g * 128 + 128 - f) * KP : (size_t)(512 + g * 128 + f) * KP;
#pragma unroll 1
        for (int dp = 0; dp < 2; ++dp) {
            f32x4 w[2][4][2];
#pragma unroll
            for (int d2 = 0; d2 < 2; ++d2)
#pragma unroll
                for (int kk = 0; kk < 4; ++kk)
#pragma unroll
                    for (int hf = 0; hf < 2; ++hf) w[d2][kk][hf] = *(const f32x4*)(src + (size_t)((dp * 2 + d2) * 16) * 3072 + kk * 32 + hf * 4);
#pragma unroll
            for (int d2 = 0; d2 < 2; ++d2) { f32x4 acc = (f32x4){0.f, 0.f, 0.f, 0.f};
#pragma unroll
                for (int kk = 0; kk < 4; ++kk) { bf16x8 Wh, Wl; split8(w[d2][kk][0], w[d2][kk][1], Wh, Wl); MFMA3(acc, Wh, Wl, Th[kk], Tl[kk]); }
                acc = acc * 0.08838834764831845f;
                const int dt = dp * 2 + d2; u32x2 v; v.x = cvt_pk_bf16(acc[0], acc[1]); v.y = cvt_pk_bf16(acc[2], acc[3]);
                *(u32x2*)(dsth + dt * 16) = v; *(u32x2*)(dstf + row0 + dt * 16) = v;
                u32x2 m; if (mir) { m = part ? (u32x2){v.x ^ 0x80008000u, v.y ^ 0x80008000u} : v; } else m = (u32x2){0u, 0u};
                *(u32x2*)(dstf + row1 + dt * 16) = m; }
        }
    }
}
__device__ __forceinline__ void p0_fold_o(LAS float* L, int c, int G, int tid) {
    const int wid = tid >> 6, lane = tid & 63, fr = lane & 15, fq = lane >> 4;
    LAS float* WO = L; constexpr int WP = 66;
    float one = 1.0f; asm volatile("" : "+v"(one));
    for (int item = c; item < DEPTH * 4 * 32; item += G) {
        const int l = item >> 7, g = (item >> 5) & 3, nc = item & 31;
        __syncthreads();
        const float* so = ARG_IN(I_WOUT) + (size_t)l * DM * DM + (size_t)(1536 + g * 128) * DM + nc * 64;
        for (int i = tid; i < 128 * 16; i += NTHR) { const int e = i >> 4, q = i & 15; const f32x4 v = *(const f32x4*)(so + (size_t)e * DM + q * 4);
            LAS float* d = WO + e * WP + q * 4; *(LAS f32x2*)d = (f32x2){v[0], v[1]}; *(LAS f32x2*)(d + 2) = (f32x2){v[2], v[3]}; }
        const float* sf = ARG_IN(I_WF) + (size_t)(l * 4 + g) * 128 * 128 + (size_t)(wid * 16 + fr) * 128 + fq * 8;
        bf16x8 Fh[4], Fl[4];
#pragma unroll
        for (int kk = 0; kk < 4; ++kk) { const f32x4 a = *(const f32x4*)(sf + kk * 32), b = *(const f32x4*)(sf + kk * 32 + 4); split8(a, b, Fh[kk], Fl[kk]); }
        __syncthreads();
        bf16_t* dst = (bf16_t*)(ARG_WS + WS_W + (size_t)l * WL_STRIDE + WL_OUT) + (size_t)(nc * 64 + fr) * KP + 1536 + g * 128 + wid * 16 + fq * 4;
#pragma unroll
        for (int nt = 0; nt < 4; ++nt) { f32x4 acc = (f32x4){0.f, 0.f, 0.f, 0.f};
#pragma unroll
            for (int kk = 0; kk < 4; ++kk) { float o[8];
#pragma unroll
                for (int j = 0; j < 8; ++j) o[j] = WO[(kk * 32 + fq * 8 + j) * WP + nt * 16 + fr];
                bf16x8 Oh, Ol; split8((f32x4){o[0], o[1], o[2], o[3]}, (f32x4){o[4], o[5], o[6], o[7]}, Oh, Ol); MFMA3(acc, Fh[kk], Fl[kk], Oh, Ol); }
            acc = acc * one;
            u32x2 v; v.x = cvt_pk_bf16(acc[0], acc[1]); v.y = cvt_pk_bf16(acc[2], acc[3]); *(u32x2*)(dst + (size_t)(nt * 16) * KP) = v; }
    }
    __syncthreads();
}
__device__ __forceinline__ void p0_tables(int gt, int NGT) {
    bf16_t* dft = (bf16_t*)(ARG_WS + WS_DFT);
    for (int i = gt; i < 4096 * 512; i += NGT) {
        const int k = i >> 9, cb = (i & 511) * 8, part = cb >> 11, n0 = cb & 2047; float v[8];
#pragma unroll
        for (int j = 0; j < 8; ++j) { const int m = (k * (n0 + j)) & 4095; const float x = (float)m * (1.f / 4096.f);
            v[j] = part ? -__builtin_amdgcn_sinf(x) * (1.f / 64.f) : __builtin_amdgcn_cosf(x) * (1.f / 64.f); }
        u32x4 o; o.x = cvt_pk_bf16(v[0], v[1]); o.y = cvt_pk_bf16(v[2], v[3]); o.z = cvt_pk_bf16(v[4], v[5]); o.w = cvt_pk_bf16(v[6], v[7]);
        *(u32x4*)(dft + (size_t)i * 8) = o;
    }
    bf16_t* dfc = (bf16_t*)(ARG_WS + WS_DFTC);
    for (int i = gt; i < 256 * 64; i += NGT) {
        const int k = i >> 6, cb = (i & 63) * 8, part = cb >> 8, n0 = cb & 255; float v[8];
#pragma unroll
        for (int j = 0; j < 8; ++j) { const int m = (k * (n0 + j)) & 255; const float x = (float)m * (1.f / 256.f);
            v[j] = part ? -__builtin_amdgcn_sinf(x) * (1.f / 16.f) : __builtin_amdgcn_cosf(x) * (1.f / 16.f); }
        u32x4 o; o.x = cvt_pk_bf16(v[0], v[1]); o.y = cvt_pk_bf16(v[2], v[3]); o.z = cvt_pk_bf16(v[4], v[5]); o.w = cvt_pk_bf16(v[6], v[7]);
        *(u32x4*)(dfc + (size_t)i * 8) = o;
    }
    f32x2* rope = (f32x2*)(ARG_WS + WS_ROPE);
    for (int i = gt; i < 64 * 32; i += NGT) { const int pos = i >> 5, fi = i & 31;
        const float inv = exp2f(-(float)fi * (13.287712379549449f / 32.f)); const float ang = (float)pos * inv; const float rev = ang * 0.15915494309189535f;
        rope[i] = (f32x2){__builtin_amdgcn_cosf(rev), __builtin_amdgcn_sinf(rev)}; }
}
__device__ __forceinline__ void p0_mod_reduce(int gt, int NGT) {
    const float* modp = (const float*)(ARG_WS + WS_MODP); float* mod = (float*)(ARG_WS + WS_MOD);
    constexpr int N4 = DEPTH * NMODROW * MODW / 4;
    for (int i = gt; i < N4; i += NGT) {
        const int l = i / (NMODROW * MODW / 4), n4 = i % (MODW / 4);
        f32x4 s = ((const f32x4*)(ARG_IN(I_BMOD) + (size_t)l * MODW))[n4];
#pragma unroll
        for (int ks = 0; ks < 8; ++ks) s += ((const f32x4*)modp)[(size_t)ks * N4 + i];
        ((f32x4*)mod)[i] = s;
    }
}

constexpr int V_GATE = 0, V_LNG = 1, V_LNB = 2, V_SH = 3, V_SC = 4;
typedef _Float16 h16x2 __attribute__((ext_vector_type(2)));
__device__ __forceinline__ unsigned pk_f16(float a, float b) { h16x2 v; v[0] = (_Float16)a; v[1] = (_Float16)b; return __builtin_bit_cast(unsigned, v); }
__device__ __forceinline__ f32x4 up_f16(u32x2 u) { const unsigned ux = u[0], uy = u[1];
    const h16x2 a = __builtin_bit_cast(h16x2, ux), b = __builtin_bit_cast(h16x2, uy); return (f32x4){(float)a[0], (float)a[1], (float)b[0], (float)b[1]}; }
__device__ __forceinline__ void stage_vec(LAS float* V, int slot, const float* src, int tid) { ((LAS f32x4*)(V + slot * DM))[tid] = ((const f32x4*)src)[tid]; }
template <bool X16> struct RowIn;
template <> struct RowIn<false> { f32x4 x[8]; u32x2 y[8]; };
template <> struct RowIn<true> { u32x2 x[8]; u32x2 y[8]; };
template <bool X16, bool HAS_Y> __device__ __forceinline__ void row_load(RowIn<X16>& R, const void* xbase, size_t row, const bf16_t* yrow, int lane) {
#pragma unroll
    for (int j = 0; j < 8; ++j) { if constexpr (X16) R.x[j] = ((const u32x2*)xbase)[row * (DM / 4) + j * 64 + lane]; else R.x[j] = ((const f32x4*)xbase)[row * (DM / 4) + j * 64 + lane]; }
    if constexpr (HAS_Y) {
#pragma unroll
        for (int j = 0; j < 8; ++j) R.y[j] = ((const u32x2*)yrow)[j * 64 + lane]; }
}
template <bool HAS_Y, bool HAS_H, bool X16IN, bool X16OUT, bool YSPLIT>
__device__ __forceinline__ void row_process(const RowIn<X16IN>& R, const bf16_t* yrow, void* xbase_out, size_t row, bf16_t* hrow, const LAS float* V, int lane) {
    f32x4 v[8];
#pragma unroll
    for (int j = 0; j < 8; ++j) { if constexpr (X16IN) v[j] = up_f16(R.x[j]); else v[j] = R.x[j]; }
    if constexpr (HAS_Y) {
        float s = 0.f;
#pragma unroll
        for (int j = 0; j < 8; ++j) { const u32x2 yy = R.y[j]; const f32x4 g = ((const LAS f32x4*)(V + V_GATE * DM))[j * 64 + lane];
            f32x4 yv = (f32x4){bf_lo(yy.x), bf_hi(yy.x), bf_lo(yy.y), bf_hi(yy.y)};
            if constexpr (YSPLIT) {
#pragma unroll
                for (int sl_ = 1; sl_ < 4; ++sl_) { const u32x2 y2 = ((const u32x2*)(yrow + (size_t)sl_ * NCTX * DM))[j * 64 + lane]; yv += (f32x4){bf_lo(y2.x), bf_hi(y2.x), bf_lo(y2.y), bf_hi(y2.y)}; } }
            v[j] = v[j] * DN_ALPHA + g * yv; s += (v[j][0] + v[j][1]) + (v[j][2] + v[j][3]); }
        const float mean = wave_sum(s, lane) * (1.f / DM); float q = 0.f;
#pragma unroll
        for (int j = 0; j < 8; ++j) { v[j] = v[j] - mean; q += (v[j][0] * v[j][0] + v[j][1] * v[j][1]) + (v[j][2] * v[j][2] + v[j][3] * v[j][3]); }
        const float rstd = 1.0f / sqrtf(wave_sum(q, lane) * (1.f / DM) + LN_EPS);
#pragma unroll
        for (int j = 0; j < 8; ++j) { const f32x4 lg = ((const LAS f32x4*)(V + V_LNG * DM))[j * 64 + lane], lb = ((const LAS f32x4*)(V + V_LNB * DM))[j * 64 + lane];
            v[j] = v[j] * rstd * lg + lb;
            if constexpr (X16OUT) { u32x2 w; w.x = pk_f16(v[j][0], v[j][1]); w.y = pk_f16(v[j][2], v[j][3]); ((u32x2*)xbase_out)[row * (DM / 4) + j * 64 + lane] = w; v[j] = up_f16(w); }
            else ((f32x4*)xbase_out)[row * (DM / 4) + j * 64 + lane] = v[j]; }
    }
    if constexpr (HAS_H) {
        float s = 0.f;
#pragma unroll
        for (int j = 0; j < 8; ++j) s += (v[j][0] + v[j][1]) + (v[j][2] + v[j][3]);
        const float mean = wave_sum(s, lane) * (1.f / DM); float q = 0.f;
#pragma unroll
        for (int j = 0; j < 8; ++j) { v[j] = v[j] - mean; q += (v[j][0] * v[j][0] + v[j][1] * v[j][1]) + (v[j][2] * v[j][2] + v[j][3] * v[j][3]); }
        const float rstd = 1.0f / sqrtf(wave_sum(q, lane) * (1.f / DM) + LN_EPS);
#pragma unroll
        for (int j = 0; j < 8; ++j) { const f32x4 sh = ((const LAS f32x4*)(V + V_SH * DM))[j * 64 + lane], sc = ((const LAS f32x4*)(V + V_SC * DM))[j * 64 + lane];
            const f32x4 h = v[j] * rstd * (sc + 1.0f) + sh; u32x2 w; w.x = cvt_pk_bf16(h[0], h[1]); w.y = cvt_pk_bf16(h[2], h[3]); ((u32x2*)hrow)[j * 64 + lane] = w; }
    }
}
template <bool HAS_Y, bool HAS_H, bool X16IN, bool X16OUT>
__device__ __forceinline__ void rowpass(const void* xin_lat, const void* xin_ctx, void* xout_lat, void* xout_ctx, const bf16_t* Y, const bf16_t* YPc, bf16_t* H,
                                        const float* gate, const float* lng, const float* lnb, const float* sh, const float* sc, bool do_ctx,
                                        LAS float* V, int c, int G, int tid, int wave, int lane) {
    if constexpr (HAS_Y) { __syncthreads(); stage_vec(V, V_LNG, lng, tid); stage_vec(V, V_LNB, lnb, tid); }
    for (int ch = c; ch < NLAT / 128; ch += G) {
        const int b = ch / (SEQ / 128);
        __syncthreads();
        if constexpr (HAS_Y) stage_vec(V, V_GATE, gate + (size_t)b * MODW, tid);
        if constexpr (HAS_H) { stage_vec(V, V_SH, sh + (size_t)b * MODW, tid); stage_vec(V, V_SC, sc + (size_t)b * MODW, tid); }
        __syncthreads();
        { RowIn<X16IN> Ra, Rb; const size_t r0 = (size_t)ch * 128 + wave;
          row_load<X16IN, HAS_Y>(Ra, xin_lat, r0, Y + r0 * DM, lane);
#pragma unroll 1
          for (int i = 0; i < 16; i += 2) { const size_t ra = r0 + (size_t)i * 8, rb = ra + 8;
              row_load<X16IN, HAS_Y>(Rb, xin_lat, rb, Y + rb * DM, lane);
              row_process<HAS_Y, HAS_H, X16IN, X16OUT, false>(Ra, Y + ra * DM, xout_lat, ra, H + ra * KP, V, lane);
              if (i + 2 < 16) row_load<X16IN, HAS_Y>(Ra, xin_lat, rb + 8, Y + (rb + 8) * DM, lane);
              row_process<HAS_Y, HAS_H, X16IN, X16OUT, false>(Rb, Y + rb * DM, xout_lat, rb, H + rb * KP, V, lane); } }
    }
    if (do_ctx) {
        bool staged = false;
        for (int ch = c; ch < NCTX / 8; ch += G) {
            if (!staged) { __syncthreads();
                if constexpr (HAS_Y) stage_vec(V, V_GATE, gate + (size_t)NB * MODW, tid);
                if constexpr (HAS_H) { stage_vec(V, V_SH, sh + (size_t)NB * MODW, tid); stage_vec(V, V_SC, sc + (size_t)NB * MODW, tid); }
                __syncthreads(); staged = true; }
            const size_t rc = (size_t)ch * 8 + wave, r = NLAT + rc;
            RowIn<X16IN> Rc; row_load<X16IN, HAS_Y>(Rc, xin_ctx, rc, YPc + rc * DM, lane);
            row_process<HAS_Y, HAS_H, X16IN, X16OUT, HAS_Y>(Rc, YPc + rc * DM, xout_ctx, rc, H + r * KP, V, lane);
        }
    }
    __syncthreads();
}

struct FoldIn { u32x4 f[4], m[4]; unsigned x[4]; };
__device__ __forceinline__ void fold_load(FoldIn& R, const bf16_t* src, int lane) {
#pragma unroll
    for (int i = 0; i < 4; ++i) { const int n0 = 8 * (lane + 64 * i); R.f[i] = *(const u32x4*)(src + n0); R.m[i] = *(const u32x4*)(src + 4088 - n0);
        R.x[i] = (unsigned)*(const unsigned short*)(src + (n0 == 0 ? 0 : 4096 - n0)); }
}
__device__ __forceinline__ void fold_emit(const FoldIn& R, int it, bf16_t* UTF, float* C2048, int lane) {
    const int rb = it & ~127, s = it & 127, part = s > 64 ? 1 : 0, fm = part ? s - 64 : s; const bool single = (fm == 0 || fm == 64);
    bf16_t* d0 = UTF + (size_t)(rb + fm) * 4096 + part * 2048;
    bf16_t* d1 = single ? UTF + (size_t)(rb + fm) * 4096 + 2048 : UTF + (size_t)(rb + 128 - fm) * 4096 + part * 2048;
    const unsigned x1 = single ? 0u : (part ? 0x80008000u : 0u), a1 = single ? 0u : 0xffffffffu;
#pragma unroll
    for (int i = 0; i < 4; ++i) {
        const int n0 = 8 * (lane + 64 * i); const u32x4 fw = R.f[i], mw = R.m[i];
        float fv[8], rv[8];
        fv[0] = bf_lo(fw.x); fv[1] = bf_hi(fw.x); fv[2] = bf_lo(fw.y); fv[3] = bf_hi(fw.y); fv[4] = bf_lo(fw.z); fv[5] = bf_hi(fw.z); fv[6] = bf_lo(fw.w); fv[7] = bf_hi(fw.w);
        rv[0] = __uint_as_float(R.x[i] << 16);
        rv[1] = bf_hi(mw.w); rv[2] = bf_lo(mw.w); rv[3] = bf_hi(mw.z); rv[4] = bf_lo(mw.z); rv[5] = bf_hi(mw.y); rv[6] = bf_lo(mw.y); rv[7] = bf_hi(mw.x);
        float o[8];
#pragma unroll
        for (int e = 0; e < 8; ++e) o[e] = part == 0 ? fv[e] + rv[e] : fv[e] - rv[e];
        if (n0 == 0) o[0] = part == 0 ? fv[0] : 0.f;
        u32x4 w; w.x = cvt_pk_bf16(o[0], o[1]); w.y = cvt_pk_bf16(o[2], o[3]); w.z = cvt_pk_bf16(o[4], o[5]); w.w = cvt_pk_bf16(o[6], o[7]);
        *(u32x4*)(d0 + n0) = w;
        *(u32x4*)(d1 + n0) = (u32x4){(w.x & a1) ^ x1, (w.y & a1) ^ x1, (w.z & a1) ^ x1, (w.w & a1) ^ x1};
        if (i == 3 && part == 0 && lane == 63) { const float c = bf_lo(mw.x); C2048[rb + fm] = c; if (!single) C2048[rb + 128 - fm] = c; }
    }
}
__device__ __forceinline__ void fold_pass(const bf16_t* UT, bf16_t* UTF, float* C2048, int gw, int NGW, int lane) {
    FoldIn Ra, Rb;
    const int per = (4096 + NGW - 1) / NGW;
    int it = gw * per; asm volatile("" : "+s"(it));
    const int end = (it + per) < 4096 ? (it + per) : 4096;
    if (it >= end) return;
    fold_load(Ra, UT + (size_t)it * 4096, lane);
#pragma unroll 1
    for (;;) {
        const int itb = it + 1; const bool hb = itb < end;
        if (hb) fold_load(Rb, UT + (size_t)itb * 4096, lane);
        fold_emit(Ra, it, UTF, C2048, lane);
        if (!hb) break;
        const int ita = itb + 1; const bool ha = ita < end;
        if (ha) fold_load(Ra, UT + (size_t)ita * 4096, lane);
        fold_emit(Rb, itb, UTF, C2048, lane);
        if (!ha) break;
        it = ita;
    }
}
__device__ __forceinline__ void conv_fix(bf16_t* Aout, const float* Gedge, const float* Uedge, const float* cw, const float* cb, int ntiles, int gt, int NGT) {
    const int nitems = ntiles * 2 * (DFF / 4);
    for (int base = gt; base < nitems; base += 3 * NGT) {
        f32x4 A[3], B[3], C[3], U[3], X0[3], X1[3], X2[3], X3[3]; bool ok[3]; bf16_t* dst[3];
#pragma unroll
        for (int k = 0; k < 3; ++k) {
            const int it0 = base + k * NGT, it = it0 < nitems ? it0 : 0;
            const int c4 = it % (DFF / 4), te = it / (DFF / 4), pm = te >> 1, bot = te & 1, col = c4 * 4;
            const int r0 = pm * 256, seqlen = r0 < NLAT ? SEQ : CTXL, t0 = r0 < NLAT ? (r0 & (SEQ - 1)) : ((r0 - NLAT) & (CTXL - 1));
            const bool send = bot ? (t0 + 256 == seqlen) : (t0 == 0);
            ok[k] = (it0 < nitems) && !send;
            const float* g0 = bot ? Gedge + ((size_t)pm * 4 + 3) * DFF : Gedge + ((size_t)pm * 4 + 0) * DFF;
            const float* gm1 = send ? g0 : (bot ? Gedge + ((size_t)pm * 4 + 2) * DFF : Gedge + ((size_t)(pm - 1) * 4 + 3) * DFF);
            const float* gp1 = send ? g0 : (bot ? Gedge + ((size_t)(pm + 1) * 4 + 0) * DFF : Gedge + ((size_t)pm * 4 + 1) * DFF);
            A[k] = *(const f32x4*)(gm1 + col); B[k] = *(const f32x4*)(g0 + col); C[k] = *(const f32x4*)(gp1 + col); U[k] = *(const f32x4*)(Uedge + ((size_t)pm * 2 + bot) * DFF + col);
            X0[k] = *(const f32x4*)(cw + col); X1[k] = *(const f32x4*)(cw + DFF + col); X2[k] = *(const f32x4*)(cw + 2 * DFF + col); X3[k] = *(const f32x4*)(cb + col);
            dst[k] = Aout + (size_t)(r0 + (bot ? 255 : 0)) * DFF + col;
        }
#pragma unroll
        for (int k = 0; k < 3; ++k) {
            float o[4];
#pragma unroll
            for (int e = 0; e < 4; ++e) { const float z = X3[k][e] + X0[k][e] * A[k][e] + X1[k][e] * B[k][e] + X2[k][e] * C[k][e]; o[e] = silu_f(z) * U[k][e]; }
            u32x2 w; w.x = cvt_pk_bf16(o[0], o[1]); w.y = cvt_pk_bf16(o[2], o[3]);
            if (ok[k]) *(u32x2*)dst[k] = w;
        }
    }
}
struct LocPlain { bf16_t* base; int ld;
    __device__ __forceinline__ void operator()(const pg8::Unit& u, int bj, bf16_t*& p, int& l) const { p = base + (size_t)u.pm * 256 * ld + u.pn * 256 + bj * 128; l = ld; } };
struct LocSplit { bf16_t* YP;
    __device__ __forceinline__ void operator()(const pg8::Unit& u, int bj, bf16_t*& p, int& l) const { p = YP + (size_t)u.kind * NCTX * DM + (size_t)u.pm * 256 * DM + u.pn * 256 + bj * 128; l = DM; } };
struct LocZ { bf16_t* CC; int row0, mul;
    __device__ __forceinline__ void operator()(const pg8::Unit& u, int bj, bf16_t*& p, int& l) const { p = CC + (size_t)(row0 + (u.pn >> 1) * mul + u.pm * 256) * KP + 1536 + (u.pn & 1) * 256 + bj * 128; l = KP; } };

__device__ __forceinline__ void attn_phase(const bf16_t* P, bf16_t* CC, const float* sink, bool do_ctx, int c, int G, char* lds, const int wave_s) {
    const int NU = 1024 + 512 + (do_ctx ? 96 : 0);
    for (int F0 = c; F0 < NU; F0 += G) {
        att::AUnit U; int F = F0;
        if (F < 1024) {
            const int i = F >> 8, cc = F & 255, xcd = cc & 7, uid = i * 32 + (cc >> 3);
            const int pair = xcd * 2 + (uid >> 6), g = (uid & 63) >> 4, qb = uid & 15, b = pair >> 1, kvh = pair & 1, h = kvh * 4 + g;
            U.q = P + (size_t)(b * SEQ + qb * 256) * PW + h * 128;
            U.k0 = P + (size_t)(b * SEQ) * PW + 1536 + kvh * 128; U.n0 = SEQ / 64;
            U.k1 = P + (size_t)(NLAT + b * CTXL) * PW + 1536 + kvh * 128;
            U.o = CC + (size_t)(b * SEQ + qb * 256) * KP + h * 128; U.win = 0; U.qk_off = 0; U.m0 = -1e30f; U.l0 = 0.f;
        } else if (F < 1536) {
            F -= 1024;
            const int i = F >> 8, cc = F & 255, xcd = cc & 7, uid = i * 32 + (cc >> 3);
            const int pair = xcd * 2 + (uid >> 5), g = (uid & 31) >> 4, qb = uid & 15, b = pair >> 1, kvh = pair & 1, h = kvh * 2 + g;
            const int q0 = qb * 256, ks = q0 >= 128 ? q0 - 128 : 0, ke = q0 + 384 <= SEQ ? q0 + 384 : SEQ;
            U.q = P + (size_t)(b * SEQ + q0) * PW + 1024 + h * 128;
            U.k0 = P + (size_t)(b * SEQ + ks) * PW + 2048 + kvh * 128; U.n0 = (ke - ks) / 64;
            U.k1 = P + (size_t)(NLAT + b * CTXL) * PW + 2048 + kvh * 128;
            U.o = CC + (size_t)(b * SEQ + q0) * KP + 1024 + h * 128; U.win = 1; U.qk_off = q0 - ks; U.m0 = sink[h] * (1.0f / att::SCALE); U.l0 = 1.f;
        } else {
            F -= 1536; U.k0 = P; U.n0 = 0; U.win = 0; U.qk_off = 0;
            if (F < 64) { const int b = F >> 3, h = F & 7, kvh = h >> 2; const bf16_t* rowp = P + (size_t)(NLAT + b * CTXL) * PW;
                U.q = rowp + h * 128; U.k1 = rowp + 1536 + kvh * 128; U.o = CC + (size_t)(NLAT + b * CTXL) * KP + h * 128; U.m0 = -1e30f; U.l0 = 0.f; }
            else { const int f2 = F - 64, b = f2 >> 2, h = f2 & 3, kvh = h >> 1; const bf16_t* rowp = P + (size_t)(NLAT + b * CTXL) * PW;
                U.q = rowp + 1024 + h * 128; U.k1 = rowp + 2048 + kvh * 128; U.o = CC + (size_t)(NLAT + b * CTXL) * KP + 1024 + h * 128; U.m0 = sink[h] * (1.0f / att::SCALE); U.l0 = 1.f; }
        }
        if (U.win) att::attn_unit<true>(U, lds, wave_s); else att::attn_unit<false>(U, lds, wave_s);
    }
}

#ifndef PHMASK
#define PHMASK 0xFFFF
#endif
#define REP_P0 1
#define REP_A 1
#define REP_C1 1
#define REP_C2 1
#define REP_D 1
#define REP_F 1
#define REP_H 1
__global__ void __launch_bounds__(NTHR, 2) fwd(Args a_unused) {
    extern __shared__ __attribute__((aligned(16))) unsigned char lds[];
    LAS unsigned char* L = (LAS unsigned char*)lds;
    const int G = gridDim.x, c = blockIdx.x;
    const int wave_s = __builtin_amdgcn_readfirstlane(threadIdx.x >> 6);
#define LANE (tid & 63)
#define WAVE wave_s
#define VCU ((G % 8 == 0) ? (c % 8) * (G / 8) + c / 8 : c)
#define GW (VCU * NWAVES + WAVE)
#define NGW (G * NWAVES)
#define GT (c * NTHR + tid)
#define NGT (G * NTHR)
    for (int u = threadIdx.x; u < (LDS_BYTES - 131072) / 4; u += NTHR) ((LAS unsigned*)(L + 131072))[u] = 0u;
    __syncthreads();
    (void)xcd_barrier_post((unsigned*)(ARG_WS + WS_CTL) + CW_BAR, (volatile LAS unsigned*)(L + MISC_OFF) + 8);
#define GRID_BAR() do { XcdBarrier bar_; bar_.bar = (unsigned*)(ARG_WS + WS_CTL) + CW_BAR; bar_.x = xb_xcc_id(); bar_.st = (volatile LAS unsigned*)(L + MISC_OFF) + 8; xcd_barrier(bar_, otid() == 0); } while (0)

    {
    const int tid = otid();
#if PHMASK & 1
    for (int rep_ = 0; rep_ < REP_P0; ++rep_) { __syncthreads();
    p0_mod(ARG_IN(I_C), ARG_IN(I_CCTX), ARG_IN(I_WMOD), (float*)(ARG_WS + WS_MODP), (LAS float*)L, GW, NGW, tid, LANE);
    p0_fold_f(c, G, tid);
    p0_fold_o((LAS float*)L, c, G, tid);
    p0_tables(GT, NGT);
    p0_transposes((LAS float*)(L + WAVE * 8448), GW, NGW, LANE);
    }
#endif
    }
    GRID_BAR();
    { const int tid = otid(); p0_mod_reduce(GT, NGT); }
    GRID_BAR();
    { const int tid = otid(); unsigned char* ws = ARG_WS; const float* mod = (const float*)(ws + WS_MOD);
      rowpass<false, true, false, false>(ARG_IN(I_X), ARG_IN(I_CTX), nullptr, nullptr, nullptr, nullptr, (bf16_t*)(ws + WS_H), nullptr, nullptr, nullptr, mod + 0 * DM, mod + 1 * DM, true, (LAS float*)L, c, G, tid, WAVE, LANE); }
    GRID_BAR();

    for (int l = 0; l < DEPTH; ++l) {
        const bool last = (l == DEPTH - 1);
#if PHMASK & 2
        for (int rep_ = 0; rep_ < REP_A; ++rep_)
        {
            unsigned char* ws = ARG_WS; const unsigned char* wl = ws + WS_W + (size_t)l * WL_STRIDE; const bf16_t* H = (const bf16_t*)(ws + WS_H);
            pg8::InOrder S{H, (const bf16_t*)(wl + WL_IN), (const bf16_t*)(wl + WL_FH), (const bf16_t*)(wl + WL_F), G, c};
            pg8::EpiIn E{(bf16_t*)(ws + WS_P), (bf16_t*)(ws + WS_UT), (bf16_t*)(ws + WS_UTC), ARG_IN(I_QG) + l * HD, ARG_IN(I_KG) + l * HD, (const f32x2*)(ws + WS_ROPE), L + XL_OFF};
            pg8::gemm_phase<pg8::EpiIn, pg8::InOrder>(L, DM, KP, S, E, wave_s);
        }
#endif
        GRID_BAR();
#if PHMASK & 4
        { const int tid = otid(); unsigned char* ws = ARG_WS; fold_pass((const bf16_t*)(ws + WS_UT), (bf16_t*)(ws + WS_UTF), (float*)(ws + WS_C2048), GW, NGW, LANE); }
#endif
        GRID_BAR();
#if PHMASK & 8
        for (int rep_ = 0; rep_ < REP_C1; ++rep_)
        { unsigned char* ws = ARG_WS; attn_phase((const bf16_t*)(ws + WS_P), (bf16_t*)(ws + WS_CC), ARG_IN(I_SINK) + l * 4, !last, c, G, (char*)lds, wave_s); }
#endif
#if PHMASK & 16
        for (int rep_ = 0; rep_ < REP_C2; ++rep_)
        {
            unsigned char* ws = ARG_WS;
            pg8::MultiOrder S; S.init((const bf16_t*)(ws + WS_DFT), (const bf16_t*)(ws + WS_UTF), SEQ, NB * 512, nullptr, nullptr, 0, 0, SEQ, G, c); S.WGM = WGM_Z;
            pg8::EpiZ E{(bf16_t*)(ws + WS_CC), (const float*)(ws + WS_C2048)};
            pg8::gemm_phase<pg8::EpiZ, pg8::MultiOrder>(L, SEQ, SEQ, S, E, wave_s);
        }
#endif
#if PHMASK & 1024
        if (!last) {
            unsigned char* ws = ARG_WS;
            pg8::MultiOrder S; S.init((const bf16_t*)(ws + WS_DFTC), (const bf16_t*)(ws + WS_UTC), CTXL, NB * 512, nullptr, nullptr, 0, 0, 2 * CTXL, G, (c + G - 96 % G) % G);
            pg8::EpiStore<LocZ> E{LocZ{(bf16_t*)(ws + WS_CC), NLAT, CTXL}};
            pg8::gemm_phase<pg8::EpiStore<LocZ>, pg8::MultiOrder>(L, 2 * CTXL, 2 * CTXL, S, E, wave_s);
        }
#endif
        GRID_BAR();
#if PHMASK & 32
        for (int rep_ = 0; rep_ < REP_D; ++rep_)
        {
            unsigned char* ws = ARG_WS; const unsigned char* wl = ws + WS_W + (size_t)l * WL_STRIDE;
            pg8::MultiOrder S; S.init((const bf16_t*)(ws + WS_CC), (const bf16_t*)(wl + WL_OUT), NLAT, DM, nullptr, nullptr, 0, 0, KP, G, c); S.WGM = WGM_D;
            pg8::EpiStore<LocPlain> E{LocPlain{(bf16_t*)(ws + WS_Y), DM}};
            pg8::gemm_phase<pg8::EpiStore<LocPlain>, pg8::MultiOrder, false>(L, DM, KP, S, E, wave_s);
            if (!last) {
                pg8::SplitKOrder S2{(const bf16_t*)(ws + WS_CC) + (size_t)NLAT * KP, (const bf16_t*)(wl + WL_OUT), KP, DM / 4, G, c};
                pg8::EpiStore<LocSplit> E2{LocSplit{(bf16_t*)(ws + WS_YP)}};
                pg8::gemm_phase<pg8::EpiStore<LocSplit>, pg8::SplitKOrder, false>(L, DM / 4, KP, S2, E2, wave_s);
            }
        }
#endif
        GRID_BAR();
#if PHMASK & 64
        {
            const int tid = otid(); unsigned char* ws = ARG_WS; const float* modl = (const float*)(ws + WS_MOD) + (size_t)l * NMODROW * MODW; void* XC = (void*)(ws + WS_XC); void* XH = (void*)(ws + WS_XH);
            if (l == 0) rowpass<true, true, false, true>(ARG_IN(I_X), ARG_IN(I_CTX), XH, XC, (const bf16_t*)(ws + WS_Y), (const bf16_t*)(ws + WS_YP), (bf16_t*)(ws + WS_H), modl + 2 * DM, ARG_IN(I_LN1G) + l * DM, ARG_IN(I_LN1B) + l * DM,
                                modl + 3 * DM, modl + 4 * DM, !last, (LAS float*)L, c, G, tid, WAVE, LANE);
            else rowpass<true, true, true, true>(XH, XC, XH, XC, (const bf16_t*)(ws + WS_Y), (const bf16_t*)(ws + WS_YP), (bf16_t*)(ws + WS_H), modl + 2 * DM, ARG_IN(I_LN1G) + l * DM, ARG_IN(I_LN1B) + l * DM,
                                modl + 3 * DM, modl + 4 * DM, !last, (LAS float*)L, c, G, tid, WAVE, LANE);
        }
#endif
        GRID_BAR();
#if PHMASK & 128
        for (int rep_ = 0; rep_ < REP_F; ++rep_)
        {
            unsigned char* ws = ARG_WS; const unsigned char* wl = ws + WS_W + (size_t)l * WL_STRIDE;
            pg8::MultiOrder S; S.init((const bf16_t*)(ws + WS_H), (const bf16_t*)(wl + WL_GU), last ? NLAT : NTOK, 2 * DFF, nullptr, nullptr, 0, 0, KP, G, c); S.WGM = WGM_F;
            pg8::EpiConv E{(bf16_t*)(ws + WS_U), (float*)(ws + WS_GEDGE), (float*)(ws + WS_UEDGE), ARG_IN(I_CONVW) + (size_t)l * 3 * DFF, ARG_IN(I_CONVB) + (size_t)l * DFF, L + XL_OFF};
            pg8::gemm_phase<pg8::EpiConv, pg8::MultiOrder>(L, DM, KP, S, E, wave_s);
        }
#endif
        GRID_BAR();
#if PHMASK & 256
        { const int tid = otid(); unsigned char* ws = ARG_WS; conv_fix((bf16_t*)(ws + WS_U), (const float*)(ws + WS_GEDGE), (const float*)(ws + WS_UEDGE), ARG_IN(I_CONVW) + (size_t)l * 3 * DFF, ARG_IN(I_CONVB) + (size_t)l * DFF, (last ? NLAT : NTOK) / 256, GT, NGT); }
#endif
        GRID_BAR();
#if PHMASK & 512
        for (int rep_ = 0; rep_ < REP_H; ++rep_)
        {
            unsigned char* ws = ARG_WS; const unsigned char* wl = ws + WS_W + (size_t)l * WL_STRIDE;
            pg8::MultiOrder S; S.init((const bf16_t*)(ws + WS_U), (const bf16_t*)(wl + WL_DN), NLAT, DM, nullptr, nullptr, 0, 0, DFF, G, c); S.WGM = WGM_H;
            pg8::EpiStore<LocPlain> E{LocPlain{(bf16_t*)(ws + WS_Y), DM}};
            pg8::gemm_phase<pg8::EpiStore<LocPlain>, pg8::MultiOrder, false>(L, DFF, DFF, S, E, wave_s);
            if (!last) {
                pg8::SplitKOrder S2{(const bf16_t*)(ws + WS_U) + (size_t)NLAT * DFF, (const bf16_t*)(wl + WL_DN), DFF, DFF / 4, G, c};
                pg8::EpiStore<LocSplit> E2{LocSplit{(bf16_t*)(ws + WS_YP)}};
                pg8::gemm_phase<pg8::EpiStore<LocSplit>, pg8::SplitKOrder, false>(L, DFF / 4, DFF, S2, E2, wave_s);
            }
        }
#endif
        GRID_BAR();
        {
            const int tid = otid(); unsigned char* ws = ARG_WS; const float* modl = (const float*)(ws + WS_MOD) + (size_t)l * NMODROW * MODW; void* XC = (void*)(ws + WS_XC); void* XH = (void*)(ws + WS_XH);
            if (!last) rowpass<true, true, true, true>(XH, XC, XH, XC, (const bf16_t*)(ws + WS_Y), (const bf16_t*)(ws + WS_YP), (bf16_t*)(ws + WS_H), modl + 5 * DM, ARG_IN(I_LN2G) + l * DM, ARG_IN(I_LN2B) + l * DM,
                                           modl + NMODROW * MODW + 0 * DM, modl + NMODROW * MODW + 1 * DM, true, (LAS float*)L, c, G, tid, WAVE, LANE);
            else rowpass<true, false, true, false>(XH, XC, ARG_OUT, XC, (const bf16_t*)(ws + WS_Y), (const bf16_t*)(ws + WS_YP), (bf16_t*)(ws + WS_H), modl + 5 * DM, ARG_IN(I_LN2G) + l * DM, ARG_IN(I_LN2B) + l * DM, nullptr, nullptr, false, (LAS float*)L, c, G, tid, WAVE, LANE);
        }
        if (!last) GRID_BAR();
    }
}

extern "C" void kernel_launch(void* const* d_in, const int* in_sizes, int n_in, void* d_out, int out_size, void* d_ws, size_t ws_size, hipStream_t stream) {
    static int grid = 0;
    if (grid == 0) {
        if (n_in != 21 || out_size != NLAT * DM || ws_size < WS_END) { fprintf(stderr, "kernel_launch: unexpected shapes (n_in %d out %d ws %zu, need ws >= %zu)\n", n_in, out_size, ws_size, (size_t)WS_END); grid = -1; return; }
        int dev = 0, cus = 0, per_cu = 0;
        if (hipGetDevice(&dev) != hipSuccess || hipDeviceGetAttribute(&cus, hipDeviceAttributeMultiprocessorCount, dev) != hipSuccess) { grid = -1; return; }
        if (hipFuncSetAttribute((const void*)fwd, hipFuncAttributeMaxDynamicSharedMemorySize, LDS_BYTES) != hipSuccess) { fprintf(stderr, "kernel_launch: hipFuncSetAttribute failed\n"); grid = -1; return; }
        if (hipOccupancyMaxActiveBlocksPerMultiprocessor(&per_cu, (const void*)fwd, NTHR, LDS_BYTES) != hipSuccess || per_cu < 1) { fprintf(stderr, "kernel_launch: occupancy query says %d blocks per CU\n", per_cu); }
        (void)hipGetLastError();
        grid = cus;
    }
    if (grid < 0) return;
    if (hipMemsetAsync((char*)d_ws + WS_CTL, 0, CTL_ZERO_BYTES, stream) != hipSuccess) return;
    Args a{};
    for (int i = 0; i < 21; ++i) a.in[i] = (const float*)d_in[i];
    a.out = (float*)d_out; a.ws = (unsigned char*)d_ws;
    hipLaunchKernelGGL(fwd, dim3(grid), dim3(NTHR), LDS_BYTES, stream, a);
}
```

```cpp
#include <hip/hip_runtime.h>
#include <cstdio>
#include <cstdint>

#define GAS __attribute__((address_space(1)))
#define LAS __attribute__((address_space(3)))
typedef unsigned short bf16_t;
typedef short bf16x8 __attribute__((ext_vector_type(8)));
typedef short s16x4 __attribute__((ext_vector_type(4)));
typedef float f32x4 __attribute__((ext_vector_type(4)));
typedef float f32x2 __attribute__((ext_vector_type(2)));
typedef float f32x16 __attribute__((ext_vector_type(16)));
typedef unsigned u32x4 __attribute__((ext_vector_type(4)));
typedef unsigned u32x2 __attribute__((ext_vector_type(2)));

constexpr int DM = 2048, NB = 8, SEQ = 4096, DEPTH = 4, CTXL = 256, HD = 128, DFF = 5632;
constexpr int NLAT = NB * SEQ, NCTX = NB * CTXL, NTOK = NLAT + NCTX;
constexpr int KP = 2112;
constexpr int PW = 2560;
constexpr int NMODROW = 9, MODW = 6 * DM;
constexpr float LN_EPS = 1e-6f;
constexpr float DN_ALPHA = 1.681792830507429f;

constexpr size_t MiB = 1u << 20;
constexpr size_t WS_CTL = 0, CTL_ZERO_BYTES = 1 * MiB;
constexpr size_t WS_MOD = 1 * MiB;
constexpr size_t WS_MODP = 3 * MiB;
constexpr size_t WS_ROPE = 17 * MiB;
constexpr size_t WS_DFTC = 17 * MiB + 65536;
constexpr size_t WS_XC = 18 * MiB;
constexpr size_t WS_DFT = 34 * MiB;
constexpr size_t WS_UTF = 66 * MiB;
constexpr size_t WS_C2048 = 17 * MiB + 65536 + 262144;
constexpr size_t WS_W = 98 * MiB;
constexpr size_t WL_IN = 0, WL_F = 11 * MiB, WL_FH = 16 * MiB, WL_OUT = 19 * MiB, WL_GU = 28 * MiB, WL_DN = 74 * MiB, WL_STRIDE = 96 * MiB;
constexpr size_t WS_H = 482 * MiB;
constexpr size_t WS_XH = 623 * MiB;
constexpr size_t WS_Y = 759 * MiB;
constexpr size_t WS_P = 759 * MiB;
constexpr size_t WS_UTC = 929 * MiB;
constexpr size_t WS_UT = 933 * MiB;
constexpr size_t WS_CC = 933 * MiB;
constexpr size_t WS_U = 1074 * MiB;
constexpr size_t WS_YP = 1448 * MiB;
constexpr size_t WS_GEDGE = 1480 * MiB;
constexpr size_t WS_UEDGE = 1492 * MiB;
constexpr size_t WS_END = 1498 * MiB;
static_assert((size_t)NTOK * PW * 2 <= 170 * MiB && (size_t)NTOK * KP * 2 <= 141 * MiB && (size_t)NTOK * DFF * 2 <= 374 * MiB && WS_W + 4 * WL_STRIDE <= WS_H, "ws map");
static_assert((size_t)2560 * KP * 2 <= 11 * MiB && (size_t)1024 * KP * 2 <= 5 * MiB && (size_t)2048 * KP * 2 <= 9 * MiB && (size_t)11264 * KP * 2 <= 46 * MiB && (size_t)512 * KP * 2 <= 3 * MiB, "weight map");
constexpr int CW_TMO = 0, CW_BAR = 4096;

constexpr int LDS_BYTES = 147456;
constexpr int MISC_OFF = 131072 + 320;
constexpr int XL_OFF = 131072 + 1024;
constexpr int NWAVES = 8, NTHR = 512;

__device__ __forceinline__ int otid_w(int wave) { int l; asm volatile("v_mbcnt_lo_u32_b32 %0, -1, 0\n\tv_mbcnt_hi_u32_b32 %0, -1, %0" : "=v"(l)); return wave * 64 + l; }
#define otid() otid_w(wave_s)
#define LDS_WAIT() asm volatile("s_waitcnt lgkmcnt(0)" ::: "memory")
#define VM_WAIT() asm volatile("s_waitcnt vmcnt(0)" ::: "memory")
__device__ __forceinline__ unsigned cvt_pk_bf16(float lo, float hi) { unsigned r; asm volatile("v_cvt_pk_bf16_f32 %0, %1, %2" : "=v"(r) : "v"(lo), "v"(hi)); return r; }
__device__ __forceinline__ float bf_lo(unsigned w) { return __uint_as_float(w << 16); }
__device__ __forceinline__ float bf_hi(unsigned w) { return __uint_as_float(w & 0xffff0000u); }

#define XB_TMO      128
#define XB_XCNT(j)  (256  + 64 * (j))
#define XB_XSUB(j)  (1280 + 64 * (j))
#define XB_XGEN(j)  (2304 + 64 * (j))
#define XB_TOP      3328
#define XB_TOPGEN   3392
#define XCD_BAR_WORDS 3456
#define XB_SPIN_CAP (1u << 18)
__device__ __forceinline__ unsigned xb_ld(unsigned* p)              { return __hip_atomic_load(p, __ATOMIC_RELAXED, __HIP_MEMORY_SCOPE_AGENT); }
__device__ __forceinline__ unsigned xb_add(unsigned* p, unsigned v) { return __hip_atomic_fetch_add(p, v, __ATOMIC_RELAXED, __HIP_MEMORY_SCOPE_AGENT); }
__device__ __forceinline__ unsigned xb_xcc_id() { return (unsigned)__builtin_amdgcn_s_getreg((3 << 11) | 20) & 0xFu; }
#define XB_SPIN(cond, bar) do { unsigned _sp = 0; while (cond) { __builtin_amdgcn_s_sleep(1); \
    if ((++_sp & 255u) == 0u) { if (xb_ld(&(bar)[XB_TMO])) break; if (_sp > XB_SPIN_CAP) { atomicAdd(&(bar)[XB_TMO], 1u); break; } } } } while (0)
struct XcdBarrier { unsigned* bar; unsigned x; volatile LAS unsigned* st; };
__device__ __forceinline__ XcdBarrier xcd_barrier_post(unsigned* bar, volatile LAS unsigned* st) {
    XcdBarrier b; b.bar = bar; b.x = xb_xcc_id(); b.st = st;
    if (threadIdx.x == 0) (void)xb_add(&bar[XB_XCNT(b.x)], 1u);
    return b;
}
__device__ __forceinline__ void xcd_barrier_complete(unsigned* bar, unsigned x, unsigned& nloc, unsigned& nx) {
    const unsigned G = gridDim.x * gridDim.y * gridDim.z;
    unsigned sum, cnt, mine, sp = 0u;
    for (;;) {
        sum = 0u; cnt = 0u; mine = 0u;
#pragma unroll
        for (unsigned j = 0; j < 16; ++j) { const unsigned c = xb_ld(&bar[XB_XCNT(j)]); sum += c; cnt += (c > 0u) ? 1u : 0u; mine = (j == x) ? c : mine; }
        if (sum == G) break;
        __builtin_amdgcn_s_sleep(1);
        if ((++sp & 255u) == 0u) { if (xb_ld(&bar[XB_TMO])) break; if (sp > XB_SPIN_CAP) { atomicAdd(&bar[XB_TMO], 1u); break; } }
    }
    nloc = mine > 0u ? mine : 1u; nx = cnt > 0u ? cnt : 1u;
}
__device__ __forceinline__ void xcd_barrier(const XcdBarrier& b, const bool leader  ) {
    asm volatile("s_waitcnt vmcnt(0)" ::: "memory");
    __syncthreads();
    if (leader) {
        unsigned* bar = b.bar;
        __builtin_amdgcn_s_waitcnt(0);
        unsigned nloc = b.st[0], nx = b.st[1];
        if (nloc == 0u) { xcd_barrier_complete(bar, b.x, nloc, nx); b.st[0] = nloc; b.st[1] = nx; }
        const unsigned old = xb_add(&bar[XB_XSUB(b.x)], 1u);
        const unsigned gen = old / nloc;
        if (old + 1u == (gen + 1u) * nloc) {
            __builtin_amdgcn_fence(__ATOMIC_RELEASE, "agent");
            asm volatile("s_waitcnt vmcnt(0)" ::: "memory");
            const unsigned og = xb_add(&bar[XB_TOP], 1u);
            const unsigned tg = og / nx;
            if (og + 1u == (tg + 1u) * nx) xb_add(&bar[XB_TOPGEN], 1u);
            else XB_SPIN(xb_ld(&bar[XB_TOPGEN]) == tg, bar);
            __builtin_amdgcn_fence(__ATOMIC_ACQUIRE, "agent");
            xb_add(&bar[XB_XGEN(b.x)], 1u);
            asm volatile("s_waitcnt vmcnt(0)" ::: "memory");
        } else {
            XB_SPIN(xb_ld(&bar[XB_XGEN(b.x)]) == gen, bar);
            __builtin_amdgcn_fence(__ATOMIC_ACQUIRE, "agent");
            asm volatile("s_waitcnt vmcnt(0)" ::: "memory");
        }
    }
    __syncthreads();
}

#ifndef WGM_A
#define WGM_A 4
#endif
#ifndef WGM_Z
#define WGM_Z 4
#endif
#ifndef WGM_D
#define WGM_D 4
#endif
#ifndef WGM_F
#define WGM_F 4
#endif
#ifndef WGM_H
#define WGM_H 2
#endif
namespace pg8 {
constexpr int BM = 256, BK = 64, HALF = 128, HTB = HALF * BK * 2, STAGE_BYTES = 8 * HTB, NXCD = 8;
__host__ __device__ __forceinline__ int lds_byte(int r, int c) { const int st = (r >> 4) * 2 + (c >> 5), rr = r & 15, cc = c & 31, ob = rr * 64 + cc * 2; return st * 1024 + (ob ^ (((ob >> 9) & 1) << 5)); }
__host__ __device__ __forceinline__ void stage_rc(int b, int& R, int& C) { const int st = b / 1024, sb = b % 1024, swz = sb ^ (((sb >> 9) & 1) << 5); R = (st >> 1) * 16 + swz / 64; C = (st & 1) * 32 + (swz % 64) / 2; }
__host__ __device__ __forceinline__ int perm32(int rho) { const int n = rho >> 4, i = rho & 15; return 8 * (i >> 2) + 4 * n + (i & 3); }

struct Unit { int pm, pn, kind; };
struct MultiOrder {
    const bf16_t *A0, *B0, *A1, *B1; int nM0, nN0, nM1, nN1, n0, ntot, G, c, K  ; int WGM = 4  ;
    __device__ void init(const bf16_t* a0, const bf16_t* b0, int M0, int N0, const bf16_t* a1, const bf16_t* b1, int M1, int N1, int K_, int G_, int c_) {
        A0 = a0; B0 = b0; nM0 = M0 / BM; nN0 = N0 / BM; A1 = a1; B1 = b1; nM1 = M1 / BM; nN1 = N1 / BM; n0 = nM0 * nN0; ntot = n0 + nM1 * nN1; K = K_; G = G_; c = c_; }
    __device__ __forceinline__ bool next(int i, Unit& u, const char*& pa, const char*& pb) const {
        const long L = (long)i * G + c; if (L >= ntot) return false;
        const int s = (L >= n0) ? 1 : 0; int wgid = s ? (int)L - n0 : (int)L;
        const int nM = s ? nM1 : nM0, nN = s ? nN1 : nN0, nwg = nM * nN;
        { const int q = nwg / NXCD, r = nwg % NXCD, xcd = wgid % NXCD, off = wgid / NXCD; wgid = (xcd < r ? xcd * (q + 1) : r * (q + 1) + (xcd - r) * q) + off; }
        const int nig = WGM * nN, gid = wgid / nig, fm = gid * WGM, gsz = (nM - fm) < WGM ? (nM - fm) : WGM;
        u.pm = fm + ((wgid % nig) % gsz); u.pn = (wgid % nig) / gsz; u.kind = s;
        const size_t tstep = (size_t)BM * K * 2;
        pa = (const char*)(s ? A1 : A0) + (size_t)u.pm * tstep; pb = (const char*)(s ? B1 : B0) + (size_t)u.pn * tstep; return true;
    }
};

struct InOrder {
    const bf16_t *H, *Win, *WFh, *WFf; int G, c;
    static constexpr int N0 = (NTOK / 256) * 10, N1 = 2 * (NLAT / 256), N2 = 4 * (NCTX / 256), NT = N0 + N1 + N2, WGM = WGM_A;
    __device__ __forceinline__ bool next(int i, Unit& u, const char*& pa, const char*& pb) const {
        const int L = i * G + c; if (L >= NT) return false;
        const int s = L < N1 ? 1 : (L < N1 + N0 ? 0 : 2); int wgid = L - (s == 1 ? 0 : (s == 0 ? N1 : N1 + N0));
        const int nM = s == 0 ? NTOK / 256 : (s == 1 ? 2 : 4), nN = s == 0 ? 10 : (s == 1 ? NLAT / 256 : NCTX / 256), nwg = nM * nN;
        { const int q = nwg / NXCD, r = nwg % NXCD, xcd = wgid % NXCD, off = wgid / NXCD; wgid = (xcd < r ? xcd * (q + 1) : r * (q + 1) + (xcd - r) * q) + off; }
        const int nig = WGM * nN, gid = wgid / nig, fm = gid * WGM, gsz = (nM - fm) < WGM ? (nM - fm) : WGM;
        u.pm = fm + ((wgid % nig) % gsz); u.pn = (wgid % nig) / gsz; u.kind = s;
        const size_t tstep = (size_t)BM * KP * 2;
        pa = (const char*)(s == 0 ? H : (s == 1 ? WFh : WFf)) + (size_t)u.pm * tstep;
        pb = (const char*)(s == 0 ? Win : H) + (size_t)(s == 2 ? u.pn + NLAT / 256 : u.pn) * tstep; return true;
    }
};
struct SplitKOrder {
    const bf16_t *A, *B; int ldk, Kx, G, c;
    __device__ __forceinline__ bool next(int i, Unit& u, const char*& pa, const char*& pb) const {
        const int L = i * G + c; if (L >= 256) return false;
        u.kind = L & 3; u.pm = (L >> 2) & 7; u.pn = L >> 5;
        pa = (const char*)A + ((size_t)u.pm * BM * ldk + (size_t)u.kind * Kx) * 2; pb = (const char*)B + ((size_t)u.pn * BM * ldk + (size_t)u.kind * Kx) * 2; return true;
    }
};
template <class Loc> struct EpiStore {
    static constexpr bool PERM = true, PERMA = false;
    Loc loc;
    __device__ __forceinline__ void prefetch(const Unit&, int, int) const {}
    __device__ __forceinline__ void operator()(const f32x4 (&acc)[2][2][4][2], const Unit& u, int wr, int wc, int fr, int fq) const {
#pragma unroll
        for (int bj = 0; bj < 2; ++bj) {
            bf16_t* p; int ld; loc(u, bj, p, ld);
            p += (size_t)(wr * 64 + fr) * ld + wc * 32 + 8 * fq;
#pragma unroll
            for (int ai = 0; ai < 2; ++ai)
#pragma unroll
                for (int m = 0; m < 4; ++m) {
                    const f32x4 v0 = acc[ai][bj][m][0], v1 = acc[ai][bj][m][1];
                    u32x4 w; w.x = cvt_pk_bf16(v0[0], v0[1]); w.y = cvt_pk_bf16(v0[2], v0[3]); w.z = cvt_pk_bf16(v1[0], v1[1]); w.w = cvt_pk_bf16(v1[2], v1[3]);
                    *(u32x4*)(p + (size_t)(ai * HALF + m * 16) * ld) = w; }
        }
    }
};

struct EpiConv {
    static constexpr bool PERM = true, PERMA = true;
    bf16_t* Aout; float* Gedge; float* Uedge; const float* cw; const float* cb; LAS unsigned char* xl;
    __device__ __forceinline__ void prefetch(const Unit& u, int wid, int lane) const {
        if (wid < 2) { const int pi = 2 * wid + (lane >> 5); const float* src = (pi < 3 ? cw + (size_t)pi * DFF : cb) + 128 * u.pn + (lane & 31) * 4;
            __builtin_amdgcn_global_load_lds((const unsigned*)src, (LAS unsigned*)(xl + wid * 1024), 16, 0, 0); }
    }
    __device__ __forceinline__ void operator()(const f32x4 (&acc)[2][2][4][2], const Unit& u, int wr, int wc, int fr, int fq) const {
        const int cbase = wc * 32 + 8 * fq;
        const LAS float* XP = (const LAS float*)xl; LAS float* XG = (LAS float*)(xl + 2048) + 2 * 128;
        f32x4 w0[2], w1[2], w2[2], bb[2];
#pragma unroll
        for (int n = 0; n < 2; ++n) { w0[n] = *(const LAS f32x4*)(XP + 0 * 128 + cbase + 4 * n); w1[n] = *(const LAS f32x4*)(XP + 1 * 128 + cbase + 4 * n); w2[n] = *(const LAS f32x4*)(XP + 2 * 128 + cbase + 4 * n); bb[n] = *(const LAS f32x4*)(XP + 3 * 128 + cbase + 4 * n); }
#pragma unroll
        for (int ai = 0; ai < 2; ++ai) { const int blk = ai * 2 + wr;
            if (fr == 0) {
#pragma unroll
                for (int n = 0; n < 2; ++n) *(LAS f32x4*)(XG + (blk * 2 + 0) * 128 + cbase + 4 * n) = acc[ai][0][0][n]; }
            if (fr == 15) {
#pragma unroll
                for (int n = 0; n < 2; ++n) *(LAS f32x4*)(XG + (blk * 2 + 1) * 128 + cbase + 4 * n) = acc[ai][0][3][n]; } }
        { const size_t gcol = (size_t)u.pn * 128 + cbase;
          if (wr == 0 && fr == 0) { float* ge = Gedge + ((size_t)u.pm * 4) * DFF + gcol; float* ue = Uedge + ((size_t)u.pm * 2 + 0) * DFF + gcol;
#pragma unroll
              for (int n = 0; n < 2; ++n) { *(LAS f32x4*)(XG + (-1 * 2 + 1) * 128 + cbase + 4 * n) = (f32x4){0.f, 0.f, 0.f, 0.f}; *(f32x4*)(ge + 4 * n) = acc[0][0][0][n]; *(f32x4*)(ge + DFF + 4 * n) = acc[0][0][1][n]; *(f32x4*)(ue + 4 * n) = acc[0][1][0][n]; } }
          if (wr == 1 && fr == 15) { float* ge = Gedge + ((size_t)u.pm * 4 + 2) * DFF + gcol; float* ue = Uedge + ((size_t)u.pm * 2 + 1) * DFF + gcol;
#pragma unroll
              for (int n = 0; n < 2; ++n) { *(LAS f32x4*)(XG + (4 * 2 + 0) * 128 + cbase + 4 * n) = (f32x4){0.f, 0.f, 0.f, 0.f}; *(f32x4*)(ge + 4 * n) = acc[1][0][2][n]; *(f32x4*)(ge + DFF + 4 * n) = acc[1][0][3][n]; *(f32x4*)(ue + 4 * n) = acc[1][1][3][n]; } } }
        asm volatile("s_waitcnt lgkmcnt(0)" ::: "memory"); __builtin_amdgcn_s_barrier(); asm volatile("" ::: "memory");
        bf16_t* pout = Aout + ((size_t)u.pm * 256 + wr * 64 + 4 * fr) * DFF + (size_t)u.pn * 128 + cbase;
#pragma unroll
        for (int ai = 0; ai < 2; ++ai) { const int blk = ai * 2 + wr;
            f32x4 res[4][2];
#pragma unroll
            for (int n = 0; n < 2; ++n) {
                const f32x4 bprev = *(const LAS f32x4*)(XG + ((blk - 1) * 2 + 1) * 128 + cbase + 4 * n);
                const f32x4 bnext = *(const LAS f32x4*)(XG + ((blk + 1) * 2 + 0) * 128 + cbase + 4 * n);
                f32x4 gp0, gn3;
#pragma unroll
                for (int j = 0; j < 4; ++j) {
                    gp0[j] = __int_as_float(__builtin_amdgcn_update_dpp(__float_as_int(bprev[j]), __float_as_int(acc[ai][0][3][n][j]), 0x111, 0xf, 0xf, false));
                    gn3[j] = __int_as_float(__builtin_amdgcn_update_dpp(__float_as_int(bnext[j]), __float_as_int(acc[ai][0][0][n][j]), 0x101, 0xf, 0xf, false)); }
#pragma unroll
                for (int m = 0; m < 4; ++m) {
                    const f32x4 gp = m == 0 ? gp0 : acc[ai][0][m == 0 ? 0 : m - 1][n];
                    const f32x4 gn = m == 3 ? gn3 : acc[ai][0][m == 3 ? 3 : m + 1][n];
                    const f32x4 z = bb[n] + w0[n] * gp + w1[n] * acc[ai][0][m][n] + w2[n] * gn;
                    const f32x4 t = z * (-1.4426950408889634f);
                    f32x4 den; den[0] = __builtin_amdgcn_exp2f(t[0]); den[1] = __builtin_amdgcn_exp2f(t[1]); den[2] = __builtin_amdgcn_exp2f(t[2]); den[3] = __builtin_amdgcn_exp2f(t[3]);
                    den = den + 1.0f;
                    f32x4 rc; rc[0] = __builtin_amdgcn_rcpf(den[0]); rc[1] = __builtin_amdgcn_rcpf(den[1]); rc[2] = __builtin_amdgcn_rcpf(den[2]); rc[3] = __builtin_amdgcn_rcpf(den[3]);
                    res[m][n] = (z * rc) * acc[ai][1][m][n]; }
            }
#pragma unroll
            for (int m = 0; m < 4; ++m) { u32x4 w; w.x = cvt_pk_bf16(res[m][0][0], res[m][0][1]); w.y = cvt_pk_bf16(res[m][0][2], res[m][0][3]); w.z = cvt_pk_bf16(res[m][1][0], res[m][1][1]); w.w = cvt_pk_bf16(res[m][1][2], res[m][1][3]);
                *(u32x4*)(pout + (size_t)(ai * HALF + m) * DFF) = w; }
        }
    }
};
struct EpiIn {
    static constexpr bool PERM = true, PERMA = false;
    bf16_t *P, *UT, *UTC; const float *qg, *kg; const f32x2* rope; LAS unsigned char* xl;
    __device__ __forceinline__ void prefetch(const Unit&, int, int) const {}
    __device__ __forceinline__ void operator()(const f32x4 (&acc)[2][2][4][2], const Unit& u, int wr, int wc, int fr, int fq) const {
        if (u.kind != 0) {
            bf16_t* base; int ld;
            if (u.kind == 1) { const int b = u.pn >> 4, n0 = (u.pn & 15) * 256; base = UT + (size_t)(b * 512 + u.pm * 256) * 4096 + n0; ld = 4096; }
            else { const int part = u.pm >> 1, f0 = (u.pm & 1) * 256, b = u.pn; base = UTC + (size_t)(b * 512 + f0) * 512 + part * 256; ld = 512; }
#pragma unroll
            for (int bj = 0; bj < 2; ++bj) { bf16_t* p = base + bj * 128 + (size_t)(wr * 64 + fr) * ld + wc * 32 + 8 * fq;
#pragma unroll
                for (int ai = 0; ai < 2; ++ai)
#pragma unroll
                    for (int m = 0; m < 4; ++m) { const f32x4 v0 = acc[ai][bj][m][0], v1 = acc[ai][bj][m][1];
                        u32x4 w; w.x = cvt_pk_bf16(v0[0], v0[1]); w.y = cvt_pk_bf16(v0[2], v0[3]); w.z = cvt_pk_bf16(v1[0], v1[1]); w.w = cvt_pk_bf16(v1[2], v1[3]);
                        *(u32x4*)(p + (size_t)(ai * HALF + m * 16) * ld) = w; } }
            return;
        }
        const int pn = u.pn;
        const bool isv = (pn == 7 || pn == 9), norm = (pn < 4 || pn == 6), latent = u.pm < NLAT / 256;
        const int lane_ = fq * 16 + fr;
        LAS float* XN = (LAS float*)xl;
        const int qb = 4 * wc + fq, axis = qb >> 3, i0 = 4 * (qb & 7);
        f32x4 ga, gb, RA0, RA1, RA2, RA3, RB0, RB1, RB2, RB3;
        { const float* g = (pn == 6 ? kg : qg) + axis * 64 + i0; ga = *(const f32x4*)g; gb = *(const f32x4*)(g + 32); }
#define EPI_IN_ROPE_LD(K, A, B) do { const int pos = axis ? (16 * (K) + fr) : ((4 * u.pm + 2 * ((K) & 1) + wr) & 63); A = *(const f32x4*)(rope + pos * 32 + i0); B = *(const f32x4*)(rope + pos * 32 + i0 + 2); } while (0)
        EPI_IN_ROPE_LD(0, RA0, RB0); EPI_IN_ROPE_LD(1, RA1, RB1); EPI_IN_ROPE_LD(2, RA2, RB2); EPI_IN_ROPE_LD(3, RA3, RB3);
#undef EPI_IN_ROPE_LD
        float rinv[2][2][4];
        if (norm) {
#pragma unroll
            for (int bj = 0; bj < 2; ++bj)
#pragma unroll
                for (int ai = 0; ai < 2; ++ai)
#pragma unroll
                    for (int m = 0; m < 4; ++m) { const f32x4 a = acc[ai][bj][m][0], b = acc[ai][bj][m][1];
                        float ss = (a[0] * a[0] + a[1] * a[1]) + (a[2] * a[2] + a[3] * a[3]) + (b[0] * b[0] + b[1] * b[1]) + (b[2] * b[2] + b[3] * b[3]);
                        { auto rr = __builtin_amdgcn_permlane16_swap(__float_as_uint(ss), __float_as_uint(ss), false, false); ss = __uint_as_float(rr[0]) + __uint_as_float(rr[1]); }
                        { auto rr = __builtin_amdgcn_permlane32_swap(__float_as_uint(ss), __float_as_uint(ss), false, false); ss = __uint_as_float(rr[0]) + __uint_as_float(rr[1]); }
                        if (fq == 0) XN[(bj * 256 + ai * HALF + wr * 64 + m * 16 + fr) * 4 + wc] = ss; }
            asm volatile("s_waitcnt lgkmcnt(0)" ::: "memory"); __builtin_amdgcn_s_barrier(); asm volatile("" ::: "memory");
#pragma unroll
            for (int bj = 0; bj < 2; ++bj)
#pragma unroll
                for (int ai = 0; ai < 2; ++ai)
#pragma unroll
                    for (int m = 0; m < 4; ++m) { const f32x4 t = *(const LAS f32x4*)(XN + (bj * 256 + ai * HALF + wr * 64 + m * 16 + fr) * 4);
                        rinv[bj][ai][m] = __builtin_amdgcn_rsqf(((t[0] + t[1]) + (t[2] + t[3])) * (1.f / 128.f) + LN_EPS); }
        }
        asm volatile("" :: "v"(ga), "v"(gb), "v"(RA0), "v"(RB0), "v"(RA1), "v"(RB1), "v"(RA2), "v"(RB2), "v"(RA3), "v"(RB3));
#define EPI_IN_STEP(AI, M, SA, SB, MA, MB) do { \
                f32x4 a = acc[AI][bj][M][0], b = acc[AI][bj][M][1]; \
                if (norm) { a = a * rinv[bj][AI][M] * ga; b = b * rinv[bj][AI][M] * gb; } \
                if (!isv && latent) {                                    \
                    const f32x4 cs01 = axis ? MA : SA, cs23 = axis ? MB : SB; \
                    const f32x4 c = (f32x4){cs01[0], cs01[2], cs23[0], cs23[2]}, sn = (f32x4){cs01[1], cs01[3], cs23[1], cs23[3]}; \
                    const f32x4 na = a * c - b * sn, nb = a * sn + b * c; a = na; b = nb; } \
                u32x4 w; w.x = cvt_pk_bf16(a[0], a[1]); w.y = cvt_pk_bf16(a[2], a[3]); w.z = cvt_pk_bf16(b[0], b[1]); w.w = cvt_pk_bf16(b[2], b[3]); \
                *(u32x4*)(p + (size_t)((AI) * HALF + (M) * 16) * PW) = w; } while (0)
#pragma unroll
        for (int bj = 0; bj < 2; ++bj) {
            bf16_t* p = P + (size_t)(u.pm * 256 + wr * 64 + fr) * PW + pn * 256 + bj * 128 + wc * 32 + 8 * fq;
            EPI_IN_STEP(0, 0, RA0, RB0, RA0, RB0); EPI_IN_STEP(0, 1, RA0, RB0, RA1, RB1); EPI_IN_STEP(0, 2, RA0, RB0, RA2, RB2); EPI_IN_STEP(0, 3, RA0, RB0, RA3, RB3);
            EPI_IN_STEP(1, 0, RA1, RB1, RA0, RB0); EPI_IN_STEP(1, 1, RA1, RB1, RA1, RB1); EPI_IN_STEP(1, 2, RA1, RB1, RA2, RB2); EPI_IN_STEP(1, 3, RA1, RB1, RA3, RB3);
        }
#undef EPI_IN_STEP
    }
};
struct EpiZ {
    static constexpr bool PERM = true, PERMA = false;
    bf16_t* CC; const float* C2048;
    __device__ __forceinline__ void prefetch(const Unit&, int, int) const {}
    __device__ __forceinline__ void operator()(const f32x4 (&acc)[2][2][4][2], const Unit& u, int wr, int wc, int fr, int fq) const {
        const float sg = (fr & 1) ? -(1.f / 64.f) : (1.f / 64.f);
        f32x4 cc0[2], cc1[2];
#pragma unroll
        for (int bj = 0; bj < 2; ++bj) { const int col = u.pn * 256 + bj * 128 + wc * 32 + 8 * fq; cc0[bj] = *(const f32x4*)(C2048 + col); cc1[bj] = *(const f32x4*)(C2048 + col + 4); }
#pragma unroll
        for (int bj = 0; bj < 2; ++bj) {
            const f32x4 c0 = cc0[bj] * sg, c1 = cc1[bj] * sg;
            bf16_t* p = CC + (size_t)((u.pn >> 1) * SEQ + u.pm * 256 + wr * 64 + fr) * KP + 1536 + (u.pn & 1) * 256 + bj * 128 + wc * 32 + 8 * fq;
#pragma unroll
            for (int ai = 0; ai < 2; ++ai)
#pragma unroll
                for (int m = 0; m < 4; ++m) {
                    const f32x4 v0 = acc[ai][bj][m][0] + c0, v1 = acc[ai][bj][m][1] + c1;
                    u32x4 w; w.x = cvt_pk_bf16(v0[0], v0[1]); w.y = cvt_pk_bf16(v0[2], v0[3]); w.z = cvt_pk_bf16(v1[0], v1[1]); w.w = cvt_pk_bf16(v1[2], v1[3]);
                    *(u32x4*)(p + (size_t)(ai * HALF + m * 16) * KP) = w; }
        }
    }
};
template <class Epi, class Sched, bool ALIGN_EPI = true, bool SP2 = true>
__device__ __forceinline__ void gemm_phase(LAS unsigned char* lds, const int K  , const int ldk  , const Sched& S, const Epi& E, const int wave_s) {
    const int tid = otid(), wid = __builtin_amdgcn_readfirstlane(tid >> 6), lane = tid & 63, wr = wid >> 2, wc = wid & 3, fr = lane & 15, fq = lane >> 4;
    const int nt = K / BK;
    unsigned voffA[2], voffB[2];
#pragma unroll
    for (int i = 0; i < 2; ++i) { int R, C; stage_rc(tid * 16 + i * 8192, R, C); const int Rb = Epi::PERM ? ((R & ~31) + perm32(R & 31)) : R;
        const int Ra = Epi::PERMA ? ((R & 64) | ((R & 15) << 2) | ((R >> 4) & 3)) : R;
        voffA[i] = (unsigned)(Ra * ldk + C) * 2u; voffB[i] = (unsigned)(Rb * ldk + C) * 2u; }
    const size_t kstep = (size_t)(BK * 2);
    const size_t hstep = (size_t)HALF * ldk * 2;
    const unsigned ldsw = (unsigned)wid * 1024u;
    const int aoff = lds_byte(wr * 64 + fr, fq * 8), boff = lds_byte(wc * 32 + fr, fq * 8);
#define PG8_SA(b, h) (((b) * 2 + (h)) * HTB)
#define PG8_SB(b, h) ((4 + (b) * 2 + (h)) * HTB)
#define PG8_STAGE(bufoff, gbase, voff) do { _Pragma("unroll") for (int _i = 0; _i < 2; ++_i) \
        __builtin_amdgcn_global_load_lds((const unsigned*)((const char*)(gbase) + (voff)[_i]), (LAS unsigned*)(lds + (bufoff) + ldsw + _i * 8192), 16, 0, 0); } while (0)
#define PG8_LDA(dst, b, h) do { _Pragma("unroll") for (int m = 0; m < 4; ++m) _Pragma("unroll") for (int k = 0; k < 2; ++k) dst[m][k] = *(const LAS bf16x8*)(lds + PG8_SA(b, h) + aoff + m * 2048 + k * 1024); } while (0)
#define PG8_LDB(dst, b, h) do { _Pragma("unroll") for (int n = 0; n < 2; ++n) _Pragma("unroll") for (int k = 0; k < 2; ++k) dst[n][k] = *(const LAS bf16x8*)(lds + PG8_SB(b, h) + boff + n * 2048 + k * 1024); } while (0)
#define PG8_MMA(ai, bj, At, Bt) do { __builtin_amdgcn_s_setprio(1); _Pragma("unroll") for (int m = 0; m < 4; ++m) _Pragma("unroll") for (int n = 0; n < 2; ++n) _Pragma("unroll") for (int k = 0; k < 2; ++k) \
        acc[ai][bj][m][n] = __builtin_amdgcn_mfma_f32_16x16x32_bf16(Bt[n][k], At[m][k], acc[ai][bj][m][n], 0, 0, 0); __builtin_amdgcn_s_setprio(0); } while (0)
#define PG8_WAIT_V(n) asm volatile("s_waitcnt vmcnt(" #n ")" ::: "memory")
#define PG8_WAIT_L(n) asm volatile("s_waitcnt lgkmcnt(" #n ")" ::: "memory")
#define PG8_BAR __builtin_amdgcn_s_barrier()
#define PG8_SCHED __builtin_amdgcn_sched_barrier(0)
    Unit cur, nxt; int ui = 0;
    const char *cA, *cB, *nA, *nB;
    if (!S.next(0, cur, cA, cB)) return;
    f32x4 acc[2][2][4][2];
#pragma unroll
    for (int a = 0; a < 2; ++a)
#pragma unroll
        for (int b = 0; b < 2; ++b)
#pragma unroll
            for (int m = 0; m < 4; ++m)
#pragma unroll
                for (int n = 0; n < 2; ++n) acc[a][b][m][n] = (f32x4){0.f, 0.f, 0.f, 0.f};
    bf16x8 At[4][2], B0[2][2], B1[2][2];
    if constexpr (SP2) {
        PG8_STAGE(PG8_SB(0, 0), cB, voffB); PG8_STAGE(PG8_SB(0, 1), cB + hstep, voffB); PG8_STAGE(PG8_SA(0, 0), cA, voffA); PG8_STAGE(PG8_SA(0, 1), cA + hstep, voffA);
        if (wr == 1) PG8_BAR;
        PG8_WAIT_V(2); PG8_BAR;
        PG8_STAGE(PG8_SB(1, 0), cB + kstep, voffB); PG8_STAGE(PG8_SA(1, 0), cA + kstep, voffA); PG8_STAGE(PG8_SB(1, 1), cB + hstep + kstep, voffB);
        PG8_WAIT_V(6); PG8_BAR;
    } else {
        PG8_STAGE(PG8_SB(0, 0), cB, voffB); PG8_STAGE(PG8_SA(0, 0), cA, voffA); PG8_STAGE(PG8_SB(0, 1), cB + hstep, voffB); PG8_STAGE(PG8_SA(0, 1), cA + hstep, voffA);
        if (wr == 1) PG8_BAR;
        PG8_WAIT_V(4); PG8_BAR;
        PG8_STAGE(PG8_SB(1, 0), cB + kstep, voffB); PG8_STAGE(PG8_SA(1, 0), cA + kstep, voffA); PG8_STAGE(PG8_SB(1, 1), cB + hstep + kstep, voffB);
        PG8_WAIT_V(6); PG8_BAR;
    }
    for (;;) {
        const bool has_next = S.next(ui + 1, nxt, nA, nB);
        if (!has_next) { nA = cA; nB = cB; }
        for (int t = 0; t < nt; t += 2) {
            const bool last = (t == nt - 2);
            const char* a1 = cA + (size_t)(t + 1) * kstep;
            const char* a2 = last ? nA : cA + (size_t)(t + 2) * kstep; const char* b2 = last ? nB : cB + (size_t)(t + 2) * kstep;
            const char* a3 = a2 + kstep; const char* b3 = b2 + kstep;
            if constexpr (SP2) {
            PG8_LDB(B0, 0, 0); PG8_LDB(B1, 0, 1); PG8_SCHED; PG8_LDA(At, 0, 0); PG8_STAGE(PG8_SA(1, 1), a1 + hstep, voffA);
            if (last) E.prefetch(cur, wid, lane);
            PG8_WAIT_V(8); PG8_WAIT_L(0); PG8_BAR; PG8_MMA(0, 0, At, B0); PG8_MMA(0, 1, At, B1); PG8_BAR; PG8_SCHED;
            PG8_LDA(At, 0, 1); PG8_STAGE(PG8_SB(0, 0), b2, voffB); PG8_STAGE(PG8_SB(0, 1), b2 + hstep, voffB); PG8_STAGE(PG8_SA(0, 0), a2, voffA);
            PG8_WAIT_V(8); PG8_WAIT_L(0); PG8_BAR; PG8_MMA(1, 0, At, B0); PG8_MMA(1, 1, At, B1); PG8_BAR; PG8_SCHED;
            PG8_LDB(B0, 1, 0); PG8_LDB(B1, 1, 1); PG8_SCHED; PG8_LDA(At, 1, 0); PG8_STAGE(PG8_SA(0, 1), a2 + hstep, voffA);
            PG8_WAIT_V(8); PG8_WAIT_L(0); PG8_BAR; PG8_MMA(0, 0, At, B0); PG8_MMA(0, 1, At, B1); PG8_BAR; PG8_SCHED;
            PG8_LDA(At, 1, 1); PG8_STAGE(PG8_SB(1, 0), b3, voffB); PG8_STAGE(PG8_SB(1, 1), b3 + hstep, voffB); PG8_STAGE(PG8_SA(1, 0), a3, voffA);
            PG8_WAIT_V(8); PG8_WAIT_L(0); PG8_BAR; PG8_MMA(1, 0, At, B0); PG8_MMA(1, 1, At, B1); PG8_BAR; PG8_SCHED;
            } else {
            PG8_LDB(B0, 0, 0); PG8_SCHED; PG8_LDA(At, 0, 0); PG8_STAGE(PG8_SA(1, 1), a1 + hstep, voffA);
            PG8_WAIT_L(8); PG8_BAR; PG8_WAIT_L(0); PG8_MMA(0, 0, At, B0); PG8_BAR; PG8_SCHED;
            PG8_LDB(B1, 0, 1); PG8_STAGE(PG8_SB(0, 0), b2, voffB);
            PG8_BAR; PG8_WAIT_L(0); PG8_MMA(0, 1, At, B1); PG8_BAR;
            PG8_LDA(At, 0, 1); PG8_STAGE(PG8_SA(0, 0), a2, voffA);
            PG8_BAR; PG8_WAIT_L(0); PG8_MMA(1, 0, At, B0); PG8_BAR; PG8_SCHED;
            PG8_STAGE(PG8_SB(0, 1), b2 + hstep, voffB);
            PG8_WAIT_V(6); PG8_BAR; PG8_MMA(1, 1, At, B1); PG8_BAR;
            PG8_LDB(B0, 1, 0); PG8_SCHED; PG8_LDA(At, 1, 0); PG8_STAGE(PG8_SA(0, 1), a2 + hstep, voffA);
            PG8_WAIT_L(8); PG8_BAR; PG8_WAIT_L(0); PG8_MMA(0, 0, At, B0); PG8_BAR; PG8_SCHED;
            PG8_LDB(B1, 1, 1); PG8_STAGE(PG8_SB(1, 0), b3, voffB);
            PG8_BAR; PG8_WAIT_L(0); PG8_MMA(0, 1, At, B1); PG8_BAR;
            PG8_LDA(At, 1, 1); PG8_STAGE(PG8_SA(1, 0), a3, voffA);
            PG8_BAR; PG8_WAIT_L(0); PG8_MMA(1, 0, At, B0); PG8_BAR; PG8_SCHED;
            PG8_STAGE(PG8_SB(1, 1), b3 + hstep, voffB);
            PG8_WAIT_V(6); PG8_BAR; PG8_MMA(1, 1, At, B1); PG8_BAR;
            }
        }
        if constexpr (ALIGN_EPI) { if (wr == 0) PG8_BAR; }
        E(acc, cur, wr, wc, fr, fq);
        if (!has_next) break;
#pragma unroll
        for (int a = 0; a < 2; ++a)
#pragma unroll
            for (int b = 0; b < 2; ++b)
#pragma unroll
                for (int m = 0; m < 4; ++m)
#pragma unroll
                    for (int n = 0; n < 2; ++n) acc[a][b][m][n] = (f32x4){0.f, 0.f, 0.f, 0.f};
        cur = nxt; cA = nA; cB = nB; ++ui;
        if constexpr (ALIGN_EPI) { if (wr == 1) PG8_BAR; }
    }
    PG8_WAIT_V(0);
    if constexpr (!ALIGN_EPI) { if (wr == 0) PG8_BAR; }
    PG8_BAR;
#undef PG8_SA
#undef PG8_SB
#undef PG8_STAGE
#undef PG8_LDA
#undef PG8_LDB
#undef PG8_MMA
#undef PG8_WAIT_V
#undef PG8_WAIT_L
#undef PG8_BAR
#undef PG8_SCHED
}
}

namespace att {
constexpr int NW = 8, QBLK = 32, KVBLK = 64;
constexpr float SCALE = 0.088388347648318440f;
constexpr float THR = 8.f;
constexpr int SHM_V = KVBLK * HD * 2, SHM_K = KVBLK * HD * 2, SHM_ATTN = 3 * SHM_V + 3 * SHM_K + NW * 64 * 4;
#define KSWZ(row, colB) ((row) * 256 + ((colB) ^ (((row) & 7) << 4)))
#define SBAR() __builtin_amdgcn_sched_barrier(0)
__device__ __forceinline__ int crow(int r, int hi) { return (r & 3) + 8 * (r >> 2) + 4 * hi; }
__device__ __forceinline__ void partialSM(f32x16& p0, f32x16& p1, float& m_reg, float& mn, float& alpha) {
  constexpr float C = SCALE * 1.4426950408889634f;
  float pmax = p0[0];
#pragma unroll
  for (int r = 1; r < 16; ++r) pmax = fmaxf(pmax, p0[r]);
#pragma unroll
  for (int r = 0; r < 16; ++r) pmax = fmaxf(pmax, p1[r]);
  { auto rr = __builtin_amdgcn_permlane32_swap(__float_as_uint(pmax), __float_as_uint(pmax), false, false);
    pmax = fmaxf(__uint_as_float(rr[0]), __uint_as_float(rr[1])); }
  if (__builtin_expect(__all(pmax - m_reg <= THR / SCALE), 1)) { mn = m_reg; alpha = 1.f; }
  else { mn = fmaxf(m_reg, pmax); alpha = __builtin_amdgcn_exp2f((m_reg - mn) * C); m_reg = mn; }
  float mnC = -mn * C;
#pragma unroll
  for (int r = 0; r < 16; ++r) p0[r] = fmaf(p0[r], C, mnC);
#pragma unroll
  for (int r = 0; r < 16; ++r) p1[r] = fmaf(p1[r], C, mnC);
#pragma unroll
  for (int r = 0; r < 16; ++r) p0[r] = __builtin_amdgcn_exp2f(p0[r]);
}
__device__ __forceinline__ void finishSM(f32x16& p0, f32x16& p1, float alpha, float& l_reg, bf16x8& pa0, bf16x8& pa1, bf16x8& pa2, bf16x8& pa3) {
#pragma unroll
  for (int r = 0; r < 16; ++r) p1[r] = __builtin_amdgcn_exp2f(p1[r]);
  float ps = 0;
#pragma unroll
  for (int r = 0; r < 16; ++r) ps += p0[r];
#pragma unroll
  for (int r = 0; r < 16; ++r) ps += p1[r];
  { auto rr = __builtin_amdgcn_permlane32_swap(__float_as_uint(ps), __float_as_uint(ps), false, false);
    ps = __uint_as_float(rr[0]) + __uint_as_float(rr[1]); }
  l_reg = l_reg * alpha + ps;
#define PK4(P, BASE, OUT) do { unsigned a0 = cvt_pk_bf16(P[BASE + 0], P[BASE + 1]), a1 = cvt_pk_bf16(P[BASE + 2], P[BASE + 3]);   \
    unsigned b0 = cvt_pk_bf16(P[BASE + 4], P[BASE + 5]), b1 = cvt_pk_bf16(P[BASE + 6], P[BASE + 7]);                              \
    auto r0 = __builtin_amdgcn_permlane32_swap(a0, b0, false, false); auto r1 = __builtin_amdgcn_permlane32_swap(a1, b1, false, false); \
    u32x4 w = {r0[0], r1[0], r0[1], r1[1]}; OUT = *reinterpret_cast<bf16x8*>(&w); } while (0)
  PK4(p0, 0, pa0); PK4(p0, 8, pa1); PK4(p1, 0, pa2); PK4(p1, 8, pa3);
#undef PK4
}
__device__ __forceinline__ void qkt(f32x16& p0, f32x16& p1, const char* Ks, const bf16x8* qr, int r32, int hi) {
  p0 = f32x16{}; p1 = f32x16{};
#pragma unroll
  for (int d0 = 0; d0 < 8; ++d0) { int cb = (d0 * 16 + hi * 8) * 2;
    bf16x8 b0 = *reinterpret_cast<const bf16x8*>(Ks + KSWZ(r32, cb));
    bf16x8 b1 = *reinterpret_cast<const bf16x8*>(Ks + KSWZ(32 + r32, cb));
    p0 = __builtin_amdgcn_mfma_f32_32x32x16_bf16(b0, qr[d0], p0, 0, 0, 0);
    p1 = __builtin_amdgcn_mfma_f32_32x32x16_bf16(b1, qr[d0], p1, 0, 0, 0); }
}
__device__ __forceinline__ void wmask(f32x16& p0, f32x16& p1, int relbase, int hi) {
#pragma unroll
  for (int r = 0; r < 16; ++r) { const int ko = (r & 3) + 8 * (r >> 2); const int d0 = relbase - ko, d1 = d0 - 32;
    if (d0 > 128 || d0 < -128) p0[r] = -1e30f; if (d1 > 128 || d1 < -128) p1[r] = -1e30f; }
}
__device__ __forceinline__ int v_st(int k, int c) { const int kk = (k & ~0xC) | ((k & 4) << 1) | ((k & 8) >> 1); return ((kk >> 3) * 4 + (c >> 5)) * 512 + ((kk & 7) * 32 + (c & 31)) * 2; }
__device__ __forceinline__ int v_rd_base(int lane) { return ((lane & 3) << 3) | (((lane >> 2) & 3) << 6) | (((lane >> 4) & 1) << 5) | (((lane >> 5) & 1) << 8); }
constexpr int v_rd_off(int d0, int ks, int half) { return d0 * 512 + ks * 4096 + half * 2048; }
template <int OFF> __device__ __forceinline__ s16x4 tr_read(int vb) {
  return __builtin_amdgcn_ds_read_tr16_b64_v4i16((LAS s16x4*)(uintptr_t)(unsigned)(vb + OFF));
}
template <int D0> __device__ __forceinline__ void pv_one(f32x16& od, int vb, bf16x8 pa0, bf16x8 pa1, bf16x8 pa2, bf16x8 pa3) {
  const s16x4 l0 = tr_read<v_rd_off(D0, 0, 0)>(vb), h0 = tr_read<v_rd_off(D0, 0, 1)>(vb), l1 = tr_read<v_rd_off(D0, 1, 0)>(vb), h1 = tr_read<v_rd_off(D0, 1, 1)>(vb);
  const s16x4 l2 = tr_read<v_rd_off(D0, 2, 0)>(vb), h2 = tr_read<v_rd_off(D0, 2, 1)>(vb), l3 = tr_read<v_rd_off(D0, 3, 0)>(vb), h3 = tr_read<v_rd_off(D0, 3, 1)>(vb);
#define PK(L, H) (bf16x8){L[0], L[1], L[2], L[3], H[0], H[1], H[2], H[3]}
  od = __builtin_amdgcn_mfma_f32_32x32x16_bf16(pa0, PK(l0, h0), od, 0, 0, 0);
  od = __builtin_amdgcn_mfma_f32_32x32x16_bf16(pa1, PK(l1, h1), od, 0, 0, 0);
  od = __builtin_amdgcn_mfma_f32_32x32x16_bf16(pa2, PK(l2, h2), od, 0, 0, 0);
  od = __builtin_amdgcn_mfma_f32_32x32x16_bf16(pa3, PK(l3, h3), od, 0, 0, 0);
#undef PK
}
__device__ __forceinline__ void pv_d0(f32x16* o, int vb, bf16x8 pa0, bf16x8 pa1, bf16x8 pa2, bf16x8 pa3) {
  pv_one<0>(o[0], vb, pa0, pa1, pa2, pa3); pv_one<1>(o[1], vb, pa0, pa1, pa2, pa3); pv_one<2>(o[2], vb, pa0, pa1, pa2, pa3); pv_one<3>(o[3], vb, pa0, pa1, pa2, pa3);
}

struct AUnit {
  const bf16_t* q;
  const bf16_t *k0; int n0;
  const bf16_t *k1;
  bf16_t* o;
  int win, qk_off;
  float m0, l0;
};
template <bool WIN>
__device__ __forceinline__ void attn_unit(const AUnit& U, char* lds, const int wave_s) {
  const int tid = otid();
  const int wid = tid >> 6, lane = tid & 63, r32 = lane & 31, hi = lane >> 5;
  char* V_lds = lds; char* K_lds = lds + 3 * SHM_V;
  float* ws = (float*)(lds + 3 * SHM_V + 3 * SHM_K) + wid * 64; float* li_l = ws; float* al_l = ws + 32;
  float m_reg = U.m0, l_reg = U.l0; f32x16 o[4] = {}; bf16x8 qr[8];
  const bf16_t* Qw = U.q + (long)(wid * QBLK + r32) * PW + hi * 8;
#pragma unroll
  for (int d0 = 0; d0 < 8; ++d0) qr[d0] = *reinterpret_cast<const bf16x8*>(Qw + d0 * 16);
  const int sr = tid >> 4, sc = (tid & 15) * 8, vst0 = v_st(sr, sc), vst1 = v_st(32 + sr, sc);
  const int vb0 = (int)(uintptr_t)V_lds + v_rd_base(lane);
  const int n0 = U.n0, NT = U.n0 + CTXL / 64;
  struct { bf16x8 vs0, vs1, ks0, ks1; } sr_[2];
#define TILE_K(t) ((t) < n0 ? U.k0 + (long)(t) * (KVBLK * PW) : U.k1 + (long)((t) - n0) * (KVBLK * PW))
#define SLOAD(i, t) do { const bf16_t* kp_ = TILE_K(t); const bf16_t* vp_ = kp_ + 256; \
    sr_[i].vs0 = *reinterpret_cast<const bf16x8*>(vp_ + (long)sr * PW + sc); sr_[i].vs1 = *reinterpret_cast<const bf16x8*>(vp_ + (long)(32 + sr) * PW + sc); \
    sr_[i].ks0 = *reinterpret_cast<const bf16x8*>(kp_ + (long)sr * PW + sc); sr_[i].ks1 = *reinterpret_cast<const bf16x8*>(kp_ + (long)(32 + sr) * PW + sc); } while (0)
#define SWRITE(bo, i) do { *(bf16x8*)(V_lds + (bo) + vst0) = sr_[i].vs0; *(bf16x8*)(V_lds + (bo) + vst1) = sr_[i].vs1; int kc = sc * 2; \
    *(bf16x8*)(K_lds + (bo) + KSWZ(sr, kc)) = sr_[i].ks0; *(bf16x8*)(K_lds + (bo) + KSWZ(32 + sr, kc)) = sr_[i].ks1; } while (0)
#define SWAIT() asm volatile("s_waitcnt vmcnt(4)" ::: "memory")
#define RESC(a) do { if (__any((a) < 1.f)) { if (hi == 0) al_l[r32] = (a); asm volatile("s_waitcnt lgkmcnt(0)" ::: "memory"); \
    _Pragma("unroll") for (int d = 0; d < 4; ++d) _Pragma("unroll") for (int r = 0; r < 16; ++r) o[d][r] *= al_l[crow(r, hi)]; } } while (0)
#define WMASK(P0, P1, t) do { if (WIN && (t) < n0) wmask(P0, P1, wid * QBLK + r32 + U.qk_off - (t) * KVBLK - 4 * hi, hi); } while (0)
  f32x16 pA0, pA1, pB0, pB1; float mnA, mnB, alA, alB; bf16x8 pa0, pa1, pa2, pa3;
  constexpr int SE = 0, SO = 1;
  static_assert(SHM_V == SHM_K, "one ring offset for both");
  SLOAD(SE, 0); asm volatile("s_waitcnt vmcnt(0)" ::: "memory"); SWRITE(0, SE); __syncthreads();
  qkt(pA0, pA1, K_lds, qr, r32, hi); WMASK(pA0, pA1, 0); partialSM(pA0, pA1, m_reg, mnA, alA);
  SLOAD(SO, 1); if (2 < NT) SLOAD(SE, 2);
  SWAIT(); SWRITE(SHM_K, SO); __syncthreads();
  int rp = 0, rc = SHM_K, rn = 2 * SHM_K;
#pragma unroll 1
  for (int j = 1; j + 1 < NT; j += 2) {
    SBAR(); qkt(pB0, pB1, K_lds + rc, qr, r32, hi);
    finishSM(pA0, pA1, alA, l_reg, pa0, pa1, pa2, pa3); SBAR();
    SLOAD(SO, j + 2); SBAR();
    pv_d0(o, vb0 + rp, pa0, pa1, pa2, pa3); WMASK(pB0, pB1, j); partialSM(pB0, pB1, m_reg, mnB, alB);
    SWAIT(); SWRITE(rn, SE);
    RESC(alB); __syncthreads();
    SBAR(); qkt(pA0, pA1, K_lds + rn, qr, r32, hi);
    finishSM(pB0, pB1, alB, l_reg, pa0, pa1, pa2, pa3); SBAR();
    if (j + 3 < NT) SLOAD(SE, j + 3); SBAR();
    pv_d0(o, vb0 + rc, pa0, pa1, pa2, pa3); WMASK(pA0, pA1, j + 1); partialSM(pA0, pA1, m_reg, mnA, alA);
    SWAIT(); SWRITE(rp, SO);
    RESC(alA); __syncthreads();
    { const int t = rp; rp = rn; rn = rc; rc = t; }
  }
  SBAR(); qkt(pB0, pB1, K_lds + rc, qr, r32, hi);
  finishSM(pA0, pA1, alA, l_reg, pa0, pa1, pa2, pa3); SBAR();
  pv_d0(o, vb0 + rp, pa0, pa1, pa2, pa3); WMASK(pB0, pB1, NT - 1); partialSM(pB0, pB1, m_reg, mnB, alB);
  RESC(alB);
  finishSM(pB0, pB1, alB, l_reg, pa0, pa1, pa2, pa3); SBAR();
  pv_d0(o, vb0 + rc, pa0, pa1, pa2, pa3);
  if (hi == 0) li_l[r32] = l_reg; asm volatile("s_waitcnt lgkmcnt(0)" ::: "memory");
  float rli[16];
#pragma unroll
  for (int r = 0; r < 16; ++r) rli[r] = __builtin_amdgcn_rcpf(li_l[crow(r, hi)]);
  bf16_t* Ow = U.o + (long)(wid * QBLK) * KP;
#pragma unroll
  for (int r = 0; r < 16; ++r) { const int orow = crow(r, hi);
#pragma unroll
    for (int d0 = 0; d0 < 4; ++d0) Ow[(long)orow * KP + d0 * 32 + r32] = (bf16_t)(cvt_pk_bf16(o[d0][r] * rli[r], 0.f) & 0xffffu); }
  __syncthreads();
#undef TILE_K
#undef SLOAD
#undef SWRITE
#undef SWAIT
#undef RESC
#undef WMASK
}
}

struct Args { const float* in[21]; float* out; unsigned char* ws; };

__device__ __forceinline__ unsigned long long karg_u64(int byte_off) {
    auto ka = __builtin_amdgcn_kernarg_segment_ptr();
    unsigned long long v; asm volatile("s_load_dwordx2 %0, %1, %2\n\ts_waitcnt lgkmcnt(0)" : "=s"(v) : "s"(ka), "i"(byte_off) : "memory"); return v; }
#define ARG_IN(i) ((const float*)(const GAS float*)karg_u64((i) * 8))
#define ARG_OUT ((float*)(GAS float*)karg_u64(21 * 8))
#define ARG_WS ((unsigned char*)(GAS unsigned char*)karg_u64(22 * 8))
enum { I_X = 0, I_C, I_CTX, I_CCTX, I_WMOD, I_BMOD, I_WIN, I_QG, I_KG, I_SINK, I_WF, I_WOUT, I_LN1G, I_LN1B, I_WUP, I_WGATE, I_CONVW, I_CONVB, I_WDOWN, I_LN2G, I_LN2B };

__device__ __forceinline__ float shfl_xor_l(float v, int o, int lane) { return __int_as_float(__builtin_amdgcn_ds_bpermute((lane ^ o) << 2, __float_as_int(v))); }
__device__ __forceinline__ float wave_sum(float v, int lane) {
    (void)lane;
    v += __int_as_float(__builtin_amdgcn_update_dpp(0, __float_as_int(v), 0xB1, 0xf, 0xf, false));
    v += __int_as_float(__builtin_amdgcn_update_dpp(0, __float_as_int(v), 0x4E, 0xf, 0xf, false));
    v += __int_as_float(__builtin_amdgcn_update_dpp(0, __float_as_int(v), 0x141, 0xf, 0xf, false));
    v += __int_as_float(__builtin_amdgcn_update_dpp(0, __float_as_int(v), 0x140, 0xf, 0xf, false));
    { auto rr = __builtin_amdgcn_permlane16_swap(__float_as_uint(v), __float_as_uint(v), false, false); v = __uint_as_float(rr[0]) + __uint_as_float(rr[1]); }
    { auto rr = __builtin_amdgcn_permlane32_swap(__float_as_uint(v), __float_as_uint(v), false, false); v = __uint_as_float(rr[0]) + __uint_as_float(rr[1]); }
    return v;
}
__device__ __forceinline__ float silu_f(float v) { return v * __builtin_amdgcn_rcpf(1.f + __expf(-v)); }

__device__ __forceinline__ void p0_mod(const float* c, const float* c_ctx, const float* w_mod, float* modp, LAS float* sl, int gw, int NGW, int tid, int lane) {
    for (int i = tid; i < NMODROW * DM; i += NTHR) { const float v = i < NB * DM ? c[i] : c_ctx[i - NB * DM]; sl[i] = v / (1.f + expf(-v)); }
    __syncthreads();
    for (int item = gw; item < DEPTH * 48 * 8; item += NGW) {
        const int l = item / 384, rem = item % 384, cc = rem >> 3, ks = rem & 7;
        const float* W = w_mod + ((size_t)l * DM + ks * 256) * MODW + cc * 256 + lane * 4;
        f32x4 acc[NMODROW];
#pragma unroll
        for (int j = 0; j < NMODROW; ++j) acc[j] = (f32x4){0.f, 0.f, 0.f, 0.f};
#pragma unroll 8
        for (int k = 0; k < 256; ++k) {
            const f32x4 w = *(const f32x4*)(W + (size_t)k * MODW);
#pragma unroll
            for (int j = 0; j < NMODROW; ++j) acc[j] += sl[j * DM + ks * 256 + k] * w;
        }
#pragma unroll
        for (int j = 0; j < NMODROW; ++j) *(f32x4*)(modp + ((size_t)((ks * DEPTH + l) * NMODROW + j)) * MODW + cc * 256 + lane * 4) = acc[j];
    }
    __syncthreads();
}
__device__ __forceinline__ void transpose_item(const float* W, size_t ldw, bf16_t* WT, size_t ldt, LAS float* scr, int lane, int lanecol  ) {
    float t_[32];
#pragma unroll
    for (int i = 0; i < 32; ++i) t_[i] = W[(size_t)(2 * i + (lane >> 5)) * ldw + lanecol];
#pragma unroll
    for (int i = 0; i < 32; ++i) scr[(2 * i + (lane >> 5)) * 33 + (lane & 31)] = t_[i];
    LDS_WAIT(); asm volatile("" ::: "memory");
    const int c = lane & 7;
#pragma unroll
    for (int j = 0; j < 4; ++j) { const int n = (lane >> 3) + 8 * j; const LAS float* s = scr + (8 * c) * 33 + n;
        u32x4 o; o.x = cvt_pk_bf16(s[0 * 33], s[1 * 33]); o.y = cvt_pk_bf16(s[2 * 33], s[3 * 33]); o.z = cvt_pk_bf16(s[4 * 33], s[5 * 33]); o.w = cvt_pk_bf16(s[6 * 33], s[7 * 33]);
        *(u32x4*)(WT + (size_t)n * ldt + 8 * c) = o; }
    LDS_WAIT(); asm volatile("" ::: "memory");
}
__host__ __device__ __forceinline__ int hperm(int p) { const int qb = p >> 3, e = p & 7; return (qb >> 3) * 64 + (e >> 2) * 32 + 4 * (qb & 7) + (e & 3); }
constexpr int TI_IN = 32 * 80, TI_OUT = 24 * 64, TI_G = 32 * 176, TI_D = 88 * 64, TI_LAYER = TI_IN + TI_OUT + 2 * TI_G + TI_D;
__device__ __forceinline__ void p0_transposes(LAS float* scr, int gw, int NGW, int lane) {
    for (int it0 = gw; it0 < DEPTH * TI_LAYER; it0 += NGW) {
        const int l = it0 / TI_LAYER; int it = it0 % TI_LAYER;
        unsigned char* wl = ARG_WS + WS_W + (size_t)l * WL_STRIDE;
        if (it < TI_IN) { const int kb = it / 80, nb = it % 80;
            const int n0 = 32 * nb, hb = n0 & ~127; const bool isqk = n0 < 1792 || (n0 >= 2048 && n0 < 2304);
            transpose_item(ARG_IN(I_WIN) + (size_t)l * DM * 3072 + (size_t)(64 * kb) * 3072, 3072, (bf16_t*)(wl + WL_IN) + (size_t)n0 * KP + 64 * kb, KP, scr, lane, isqk ? hb + hperm(n0 - hb + (lane & 31)) : n0 + (lane & 31)); continue; }
        it -= TI_IN;
        if (it < TI_OUT) { const int kb = it / 64, nb = it % 64;
            transpose_item(ARG_IN(I_WOUT) + (size_t)l * DM * DM + (size_t)(64 * kb) * DM + 32 * nb, DM, (bf16_t*)(wl + WL_OUT) + (size_t)(32 * nb) * KP + 64 * kb, KP, scr, lane, lane & 31); continue; }
        it -= TI_OUT;
        if (it < 2 * TI_G) { const int up = it >= TI_G; if (up) it -= TI_G; const int kb = it / 176, nb = it % 176, n0 = 32 * nb, drow = 256 * (n0 >> 7) + (n0 & 127) + (up ? 128 : 0);
            transpose_item((up ? ARG_IN(I_WUP) : ARG_IN(I_WGATE)) + (size_t)l * DM * DFF + (size_t)(64 * kb) * DFF + n0, DFF, (bf16_t*)(wl + WL_GU) + (size_t)drow * KP + 64 * kb, KP, scr, lane, lane & 31); continue; }
        it -= 2 * TI_G;
        { const int kb = it / 64, nb = it % 64;
            transpose_item(ARG_IN(I_WDOWN) + (size_t)l * DFF * DM + (size_t)(64 * kb) * DM + 32 * nb, DM, (bf16_t*)(wl + WL_DN) + (size_t)(32 * nb) * DFF + 64 * kb, DFF, scr, lane, lane & 31); }
    }
}
__device__ __forceinline__ void split8(const f32x4 a, const f32x4 b, bf16x8& hi, bf16x8& lo) {
    u32x4 h, r;
    h.x = cvt_pk_bf16(a[0], a[1]); h.y = cvt_pk_bf16(a[2], a[3]); h.z = cvt_pk_bf16(b[0], b[1]); h.w = cvt_pk_bf16(b[2], b[3]);
    r.x = cvt_pk_bf16(a[0] - bf_lo(h.x), a[1] - bf_hi(h.x)); r.y = cvt_pk_bf16(a[2] - bf_lo(h.y), a[3] - bf_hi(h.y));
    r.z = cvt_pk_bf16(b[0] - bf_lo(h.z), b[1] - bf_hi(h.z)); r.w = cvt_pk_bf16(b[2] - bf_lo(h.w), b[3] - bf_hi(h.w));
    hi = __builtin_bit_cast(bf16x8, h); lo = __builtin_bit_cast(bf16x8, r);
}
#define MFMA3(acc, Ah, Al, Bh, Bl) do { acc = __builtin_amdgcn_mfma_f32_16x16x32_bf16(Ah, Bh, acc, 0, 0, 0); acc = __builtin_amdgcn_mfma_f32_16x16x32_bf16(Ah, Bl, acc, 0, 0, 0); \
    acc = __builtin_amdgcn_mfma_f32_16x16x32_bf16(Al, Bh, acc, 0, 0, 0); } while (0)
__device__ __forceinline__ void p0_fold_f(int c, int G, int tid) {
    const int wid = tid >> 6, lane = tid & 63, fr = lane & 15, fq = lane >> 4;
    const int slot = wid * 16 + fr, part = slot > 64 ? 1 : 0, f = part ? slot - 64 : slot;
    bf16x8 Th[4], Tl[4];
#pragma unroll
    for (int kk = 0; kk < 4; ++kk) { float t[8];
#pragma unroll
        for (int j = 0; j < 8; ++j) { const int cc = kk * 32 + fq * 8 + j; const float x = (float)((f * cc) & 127) * (1.f / 128.f);
            t[j] = part ? __builtin_amdgcn_sinf(x) : __builtin_amdgcn_cosf(x); }
        split8((f32x4){t[0], t[1], t[2], t[3]}, (f32x4){t[4], t[5], t[6], t[7]}, Th[kk], Tl[kk]); }
    const bool mir = (f != 0 && f != 64);
    for (int item = c; item < DEPTH * 4 * 32; item += G) {
        const int l = item >> 7, g = (item >> 5) & 3, dc = item & 31;
        const float* src = ARG_IN(I_WIN) + (size_t)l * DM * 3072 + (size_t)(dc * 64 + fr) * 3072 + 2560 + g * 128 + fq * 8;
        bf16_t* dstf = (bf16_t*)(ARG_WS + WS_W + (size_t)l * WL_STRIDE + WL_F) + dc * 64 + fq * 4;
        bf16_t* dsth = (bf16_t*)(ARG_WS + WS_W + (size_t)l * WL_STRIDE + WL_FH) + (size_t)(g * 128 + slot) * KP + dc * 64 + fq * 4;
        const size_t row0 = (size_t)(part * 512 + g * 128 + f) * KP, row1 = mir ? (size_t)(part * 512 + g * 128 + 128 - f) * KP : (size_t)(512 + g * 128 + f) * KP;
#pragma unroll 1
        for (int dp = 0; dp < 2; ++dp) {
            f32x4 w[2][4][2];
#pragma unroll
            for (int d2 = 0; d2 < 2; ++d2)
#pragma unroll
                for (int kk = 0; kk < 4; ++kk)
#pragma unroll
                    for (int hf = 0; hf < 2; ++hf) w[d2][kk][hf] = *(const f32x4*)(src + (size_t)((dp * 2 + d2) * 16) * 3072 + kk * 32 + hf * 4);
#pragma unroll
            for (int d2 = 0; d2 < 2; ++d2) { f32x4 acc = (f32x4){0.f, 0.f, 0.f, 0.f};
#pragma unroll
                for (int kk = 0; kk < 4; ++kk) { bf16x8 Wh, Wl; split8(w[d2][kk][0], w[d2][kk][1], Wh, Wl); MFMA3(acc, Wh, Wl, Th[kk], Tl[kk]); }
                acc = acc * 0.08838834764831845f;
                const int dt = dp * 2 + d2; u32x2 v; v.x = cvt_pk_bf16(acc[0], acc[1]); v.y = cvt_pk_bf16(acc[2], acc[3]);
                *(u32x2*)(dsth + dt * 16) = v; *(u32x2*)(dstf + row0 + dt * 16) = v;
                u32x2 m; if (mir) { m = part ? (u32x2){v.x ^ 0x80008000u, v.y ^ 0x80008000u} : v; } else m = (u32x2){0u, 0u};
                *(u32x2*)(dstf + row1 + dt * 16) = m; }
        }
    }
}
__device__ __forceinline__ void p0_fold_o(LAS float* L, int c, int G, int tid) {
    const int wid = tid >> 6, lane = tid & 63, fr = lane & 15, fq = lane >> 4;
    LAS float* WO = L; constexpr int WP = 66;
    float one = 1.0f; asm volatile("" : "+v"(one));
    for (int item = c; item < DEPTH * 4 * 32; item += G) {
        const int l = item >> 7, g = (item >> 5) & 3, nc = item & 31;
        __syncthreads();
        const float* so = ARG_IN(I_WOUT) + (size_t)l * DM * DM + (size_t)(1536 + g * 128) * DM + nc * 64;
        for (int i = tid; i < 128 * 16; i += NTHR) { const int e = i >> 4, q = i & 15; const f32x4 v = *(const f32x4*)(so + (size_t)e * DM + q * 4);
            LAS float* d = WO + e * WP + q * 4; *(LAS f32x2*)d = (f32x2){v[0], v[1]}; *(LAS f32x2*)(d + 2) = (f32x2){v[2], v[3]}; }
        const float* sf = ARG_IN(I_WF) + (size_t)(l * 4 + g) * 128 * 128 + (size_t)(wid * 16 + fr) * 128 + fq * 8;
        bf16x8 Fh[4], Fl[4];
#pragma unroll
        for (int kk = 0; kk < 4; ++kk) { const f32x4 a = *(const f32x4*)(sf + kk * 32), b = *(const f32x4*)(sf + kk * 32 + 4); split8(a, b, Fh[kk], Fl[kk]); }
        __syncthreads();
        bf16_t* dst = (bf16_t*)(ARG_WS + WS_W + (size_t)l * WL_STRIDE + WL_OUT) + (size_t)(nc * 64 + fr) * KP + 1536 + g * 128 + wid * 16 + fq * 4;
#pragma unroll
        for (int nt = 0; nt < 4; ++nt) { f32x4 acc = (f32x4){0.f, 0.f, 0.f, 0.f};
#pragma unroll
            for (int kk = 0; kk < 4; ++kk) { float o[8];
#pragma unroll
                for (int j = 0; j < 8; ++j) o[j] = WO[(kk * 32 + fq * 8 + j) * WP + nt * 16 + fr];
                bf16x8 Oh, Ol; split8((f32x4){o[0], o[1], o[2], o[3]}, (f32x4){o[4], o[5], o[6], o[7]}, Oh, Ol); MFMA3(acc, Fh[kk], Fl[kk], Oh, Ol); }
            acc = acc * one;
            u32x2 v; v.x = cvt_pk_bf16(acc[0], acc[1]); v.y = cvt_pk_bf16(acc[2], acc[3]); *(u32x2*)(dst + (size_t)(nt * 16) * KP) = v; }
    }
    __syncthreads();
}
__device__ __forceinline__ void p0_tables(int gt, int NGT) {
    bf16_t* dft = (bf16_t*)(ARG_WS + WS_DFT);
    for (int i = gt; i < 4096 * 512; i += NGT) {
        const int k = i >> 9, cb = (i & 511) * 8, part = cb >> 11, n0 = cb & 2047; float v[8];
#pragma unroll
        for (int j = 0; j < 8; ++j) { const int m = (k * (n0 + j)) & 4095; const float x = (float)m * (1.f / 4096.f);
            v[j] = part ? -__builtin_amdgcn_sinf(x) * (1.f / 64.f) : __builtin_amdgcn_cosf(x) * (1.f / 64.f); }
        u32x4 o; o.x = cvt_pk_bf16(v[0], v[1]); o.y = cvt_pk_bf16(v[2], v[3]); o.z = cvt_pk_bf16(v[4], v[5]); o.w = cvt_pk_bf16(v[6], v[7]);
        *(u32x4*)(dft + (size_t)i * 8) = o;
    }
    bf16_t* dfc = (bf16_t*)(ARG_WS + WS_DFTC);
    for (int i = gt; i < 256 * 64; i += NGT) {
        const int k = i >> 6, cb = (i & 63) * 8, part = cb >> 8, n0 = cb & 255; float v[8];
#pragma unroll
        for (int j = 0; j < 8; ++j) { const int m = (k * (n0 + j)) & 255; const float x = (float)m * (1.f / 256.f);
            v[j] = part ? -__builtin_amdgcn_sinf(x) * (1.f / 16.f) : __builtin_amdgcn_cosf(x) * (1.f / 16.f); }
        u32x4 o; o.x = cvt_pk_bf16(v[0], v[1]); o.y = cvt_pk_bf16(v[2], v[3]); o.z = cvt_pk_bf16(v[4], v[5]); o.w = cvt_pk_bf16(v[6], v[7]);
        *(u32x4*)(dfc + (size_t)i * 8) = o;
    }
    f32x2* rope = (f32x2*)(ARG_WS + WS_ROPE);
    for (int i = gt; i < 64 * 32; i += NGT) { const int pos = i >> 5, fi = i & 31;
        const float inv = exp2f(-(float)fi * (13.287712379549449f / 32.f)); const float ang = (float)pos * inv; const float rev = ang * 0.15915494309189535f;
        rope[i] = (f32x2){__builtin_amdgcn_cosf(rev), __builtin_amdgcn_sinf(rev)}; }
}
__device__ __forceinline__ void p0_mod_reduce(int gt, int NGT) {
    const float* modp = (const float*)(ARG_WS + WS_MODP); float* mod = (float*)(ARG_WS + WS_MOD);
    constexpr int N4 = DEPTH * NMODROW * MODW / 4;
    for (int i = gt; i < N4; i += NGT) {
        const int l = i / (NMODROW * MODW / 4), n4 = i % (MODW / 4);
        f32x4 s = ((const f32x4*)(ARG_IN(I_BMOD) + (size_t)l * MODW))[n4];
#pragma unroll
        for (int ks = 0; ks < 8; ++ks) s += ((const f32x4*)modp)[(size_t)ks * N4 + i];
        ((f32x4*)mod)[i] = s;
    }
}

constexpr int V_GATE = 0, V_LNG = 1, V_LNB = 2, V_SH = 3, V_SC = 4;
typedef _Float16 h16x2 __attribute__((ext_vector_type(2)));
__device__ __forceinline__ unsigned pk_f16(float a, float b) { h16x2 v; v[0] = (_Float16)a; v[1] = (_Float16)b; return __builtin_bit_cast(unsigned, v); }
__device__ __forceinline__ f32x4 up_f16(u32x2 u) { const unsigned ux = u[0], uy = u[1];
    const h16x2 a = __builtin_bit_cast(h16x2, ux), b = __builtin_bit_cast(h16x2, uy); return (f32x4){(float)a[0], (float)a[1], (float)b[0], (float)b[1]}; }
__device__ __forceinline__ void stage_vec(LAS float* V, int slot, const float* src, int tid) { ((LAS f32x4*)(V + slot * DM))[tid] = ((const f32x4*)src)[tid]; }
template <bool X16> struct RowIn;
template <> struct RowIn<false> { f32x4 x[8]; u32x2 y[8]; };
template <> struct RowIn<true> { u32x2 x[8]; u32x2 y[8]; };
template <bool X16, bool HAS_Y> __device__ __forceinline__ void row_load(RowIn<X16>& R, const void* xbase, size_t row, const bf16_t* yrow, int lane) {
#pragma unroll
    for (int j = 0; j < 8; ++j) { if constexpr (X16) R.x[j] = ((const u32x2*)xbase)[row * (DM / 4) + j * 64 + lane]; else R.x[j] = ((const f32x4*)xbase)[row * (DM / 4) + j * 64 + lane]; }
    if constexpr (HAS_Y) {
#pragma unroll
        for (int j = 0; j < 8; ++j) R.y[j] = ((const u32x2*)yrow)[j * 64 + lane]; }
}
template <bool HAS_Y, bool HAS_H, bool X16IN, bool X16OUT, bool YSPLIT>
__device__ __forceinline__ void row_process(const RowIn<X16IN>& R, const bf16_t* yrow, void* xbase_out, size_t row, bf16_t* hrow, const LAS float* V, int lane) {
    f32x4 v[8];
#pragma unroll
    for (int j = 0; j < 8; ++j) { if constexpr (X16IN) v[j] = up_f16(R.x[j]); else v[j] = R.x[j]; }
    if constexpr (HAS_Y) {
        float s = 0.f;
#pragma unroll
        for (int j = 0; j < 8; ++j) { const u32x2 yy = R.y[j]; const f32x4 g = ((const LAS f32x4*)(V + V_GATE * DM))[j * 64 + lane];
            f32x4 yv = (f32x4){bf_lo(yy.x), bf_hi(yy.x), bf_lo(yy.y), bf_hi(yy.y)};
            if constexpr (YSPLIT) {
#pragma unroll
                for (int sl_ = 1; sl_ < 4; ++sl_) { const u32x2 y2 = ((const u32x2*)(yrow + (size_t)sl_ * NCTX * DM))[j * 64 + lane]; yv += (f32x4){bf_lo(y2.x), bf_hi(y2.x), bf_lo(y2.y), bf_hi(y2.y)}; } }
            v[j] = v[j] * DN_ALPHA + g * yv; s += (v[j][0] + v[j][1]) + (v[j][2] + v[j][3]); }
        const float mean = wave_sum(s, lane) * (1.f / DM); float q = 0.f;
#pragma unroll
        for (int j = 0; j < 8; ++j) { v[j] = v[j] - mean; q += (v[j][0] * v[j][0] + v[j][1] * v[j][1]) + (v[j][2] * v[j][2] + v[j][3] * v[j][3]); }
        const float rstd = 1.0f / sqrtf(wave_sum(q, lane) * (1.f / DM) + LN_EPS);
#pragma unroll
        for (int j = 0; j < 8; ++j) { const f32x4 lg = ((const LAS f32x4*)(V + V_LNG * DM))[j * 64 + lane], lb = ((const LAS f32x4*)(V + V_LNB * DM))[j * 64 + lane];
            v[j] = v[j] * rstd * lg + lb;
            if constexpr (X16OUT) { u32x2 w; w.x = pk_f16(v[j][0], v[j][1]); w.y = pk_f16(v[j][2], v[j][3]); ((u32x2*)xbase_out)[row * (DM / 4) + j * 64 + lane] = w; v[j] = up_f16(w); }
            else ((f32x4*)xbase_out)[row * (DM / 4) + j * 64 + lane] = v[j]; }
    }
    if constexpr (HAS_H) {
        float s = 0.f;
#pragma unroll
        for (int j = 0; j < 8; ++j) s += (v[j][0] + v[j][1]) + (v[j][2] + v[j][3]);
        const float mean = wave_sum(s, lane) * (1.f / DM); float q = 0.f;
#pragma unroll
        for (int j = 0; j < 8; ++j) { v[j] = v[j] - mean; q += (v[j][0] * v[j][0] + v[j][1] * v[j][1]) + (v[j][2] * v[j][2] + v[j][3] * v[j][3]); }
        const float rstd = 1.0f / sqrtf(wave_sum(q, lane) * (1.f / DM) + LN_EPS);
#pragma unroll
        for (int j = 0; j < 8; ++j) { const f32x4 sh = ((const LAS f32x4*)(V + V_SH * DM))[j * 64 + lane], sc = ((const LAS f32x4*)(V + V_SC * DM))[j * 64 + lane];
            const f32x4 h = v[j] * rstd * (sc + 1.0f) + sh; u32x2 w; w.x = cvt_pk_bf16(h[0], h[1]); w.y = cvt_pk_bf16(h[2], h[3]); ((u32x2*)hrow)[j * 64 + lane] = w; }
    }
}
template <bool HAS_Y, bool HAS_H, bool X16IN, bool X16OUT>
__device__ __forceinline__ void rowpass(const void* xin_lat, const void* xin_ctx, void* xout_lat, void* xout_ctx, const bf16_t* Y, const bf16_t* YPc, bf16_t* H,
                                        const float* gate, const float* lng, const float* lnb, const float* sh, const float* sc, bool do_ctx,
                                        LAS float* V, int c, int G, int tid, int wave, int lane) {
    if constexpr (HAS_Y) { __syncthreads(); stage_vec(V, V_LNG, lng, tid); stage_vec(V, V_LNB, lnb, tid); }
    for (int ch = c; ch < NLAT / 128; ch += G) {
        const int b = ch / (SEQ / 128);
        __syncthreads();
        if constexpr (HAS_Y) stage_vec(V, V_GATE, gate + (size_t)b * MODW, tid);
        if constexpr (HAS_H) { stage_vec(V, V_SH, sh + (size_t)b * MODW, tid); stage_vec(V, V_SC, sc + (size_t)b * MODW, tid); }
        __syncthreads();
        { RowIn<X16IN> Ra, Rb; const size_t r0 = (size_t)ch * 128 + wave;
          row_load<X16IN, HAS_Y>(Ra, xin_lat, r0, Y + r0 * DM, lane);
#pragma unroll 1
          for (int i = 0; i < 16; i += 2) { const size_t ra = r0 + (size_t)i * 8, rb = ra + 8;
              row_load<X16IN, HAS_Y>(Rb, xin_lat, rb, Y + rb * DM, lane);
              row_process<HAS_Y, HAS_H, X16IN, X16OUT, false>(Ra, Y + ra * DM, xout_lat, ra, H + ra * KP, V, lane);
              if (i + 2 < 16) row_load<X16IN, HAS_Y>(Ra, xin_lat, rb + 8, Y + (rb + 8) * DM, lane);
              row_process<HAS_Y, HAS_H, X16IN, X16OUT, false>(Rb, Y + rb * DM, xout_lat, rb, H + rb * KP, V, lane); } }
    }
    if (do_ctx) {
        bool staged = false;
        for (int ch = c; ch < NCTX / 8; ch += G) {
            if (!staged) { __syncthreads();
                if constexpr (HAS_Y) stage_vec(V, V_GATE, gate + (size_t)NB * MODW, tid);
                if constexpr (HAS_H) { stage_vec(V, V_SH, sh + (size_t)NB * MODW, tid); stage_vec(V, V_SC, sc + (size_t)NB * MODW, tid); }
                __syncthreads(); staged = true; }
            const size_t rc = (size_t)ch * 8 + wave, r = NLAT + rc;
            RowIn<X16IN> Rc; row_load<X16IN, HAS_Y>(Rc, xin_ctx, rc, YPc + rc * DM, lane);
            row_process<HAS_Y, HAS_H, X16IN, X16OUT, HAS_Y>(Rc, YPc + rc * DM, xout_ctx, rc, H + r * KP, V, lane);
        }
    }
    __syncthreads();
}

struct FoldIn { u32x4 f[4], m[4]; unsigned x[4]; };
__device__ __forceinline__ void fold_load(FoldIn& R, const bf16_t* src, int lane) {
#pragma unroll
    for (int i = 0; i < 4; ++i) { const int n0 = 8 * (lane + 64 * i); R.f[i] = *(const u32x4*)(src + n0); R.m[i] = *(const u32x4*)(src + 4088 - n0);
        R.x[i] = (unsigned)*(const unsigned short*)(src + (n0 == 0 ? 0 : 4096 - n0)); }
}
__device__ __forceinline__ void fold_emit(const FoldIn& R, int it, bf16_t* UTF, float* C2048, int lane) {
    const int rb = it & ~127, s = it & 127, part = s > 64 ? 1 : 0, fm = part ? s - 64 : s; const bool single = (fm == 0 || fm == 64);
    bf16_t* d0 = UTF + (size_t)(rb + fm) * 4096 + part * 2048;
    bf16_t* d1 = single ? UTF + (size_t)(rb + fm) * 4096 + 2048 : UTF + (size_t)(rb + 128 - fm) * 4096 + part * 2048;
    const unsigned x1 = single ? 0u : (part ? 0x80008000u : 0u), a1 = single ? 0u : 0xffffffffu;
#pragma unroll
    for (int i = 0; i < 4; ++i) {
        const int n0 = 8 * (lane + 64 * i); const u32x4 fw = R.f[i], mw = R.m[i];
        float fv[8], rv[8];
        fv[0] = bf_lo(fw.x); fv[1] = bf_hi(fw.x); fv[2] = bf_lo(fw.y); fv[3] = bf_hi(fw.y); fv[4] = bf_lo(fw.z); fv[5] = bf_hi(fw.z); fv[6] = bf_lo(fw.w); fv[7] = bf_hi(fw.w);
        rv[0] = __uint_as_float(R.x[i] << 16);
        rv[1] = bf_hi(mw.w); rv[2] = bf_lo(mw.w); rv[3] = bf_hi(mw.z); rv[4] = bf_lo(mw.z); rv[5] = bf_hi(mw.y); rv[6] = bf_lo(mw.y); rv[7] = bf_hi(mw.x);
        float o[8];
#pragma unroll
        for (int e = 0; e < 8; ++e) o[e] = part == 0 ? fv[e] + rv[e] : fv[e] - rv[e];
        if (n0 == 0) o[0] = part == 0 ? fv[0] : 0.f;
        u32x4 w; w.x = cvt_pk_bf16(o[0], o[1]); w.y = cvt_pk_bf16(o[2], o[3]); w.z = cvt_pk_bf16(o[4], o[5]); w.w = cvt_pk_bf16(o[6], o[7]);
        *(u32x4*)(d0 + n0) = w;
        *(u32x4*)(d1 + n0) = (u32x4){(w.x & a1) ^ x1, (w.y & a1) ^ x1, (w.z & a1) ^ x1, (w.w & a1) ^ x1};
        if (i == 3 && part == 0 && lane == 63) { const float c = bf_lo(mw.x); C2048[rb + fm] = c; if (!single) C2048[rb + 128 - fm] = c; }
    }
}
__device__ __forceinline__ void fold_pass(const bf16_t* UT, bf16_t* UTF, float* C2048, int gw, int NGW, int lane) {
    FoldIn Ra, Rb;
    const int per = (4096 + NGW - 1) / NGW;
    int it = gw * per; asm volatile("" : "+s"(it));
    const int end = (it + per) < 4096 ? (it + per) : 4096;
    if (it >= end) return;
    fold_load(Ra, UT + (size_t)it * 4096, lane);
#pragma unroll 1
    for (;;) {
        const int itb = it + 1; const bool hb = itb < end;
        if (hb) fold_load(Rb, UT + (size_t)itb * 4096, lane);
        fold_emit(Ra, it, UTF, C2048, lane);
        if (!hb) break;
        const int ita = itb + 1; const bool ha = ita < end;
        if (ha) fold_load(Ra, UT + (size_t)ita * 4096, lane);
        fold_emit(Rb, itb, UTF, C2048, lane);
        if (!ha) break;
        it = ita;
    }
}
__device__ __forceinline__ void conv_fix(bf16_t* Aout, const float* Gedge, const float* Uedge, const float* cw, const float* cb, int ntiles, int gt, int NGT) {
    const int nitems = ntiles * 2 * (DFF / 4);
    for (int base = gt; base < nitems; base += 3 * NGT) {
        f32x4 A[3], B[3], C[3], U[3], X0[3], X1[3], X2[3], X3[3]; bool ok[3]; bf16_t* dst[3];
#pragma unroll
        for (int k = 0; k < 3; ++k) {
            const int it0 = base + k * NGT, it = it0 < nitems ? it0 : 0;
            const int c4 = it % (DFF / 4), te = it / (DFF / 4), pm = te >> 1, bot = te & 1, col = c4 * 4;
            const int r0 = pm * 256, seqlen = r0 < NLAT ? SEQ : CTXL, t0 = r0 < NLAT ? (r0 & (SEQ - 1)) : ((r0 - NLAT) & (CTXL - 1));
            const bool send = bot ? (t0 + 256 == seqlen) : (t0 == 0);
            ok[k] = (it0 < nitems) && !send;
            const float* g0 = bot ? Gedge + ((size_t)pm * 4 + 3) * DFF : Gedge + ((size_t)pm * 4 + 0) * DFF;
            const float* gm1 = send ? g0 : (bot ? Gedge + ((size_t)pm * 4 + 2) * DFF : Gedge + ((size_t)(pm - 1) * 4 + 3) * DFF);
            const float* gp1 = send ? g0 : (bot ? Gedge + ((size_t)(pm + 1) * 4 + 0) * DFF : Gedge + ((size_t)pm * 4 + 1) * DFF);
            A[k] = *(const f32x4*)(gm1 + col); B[k] = *(const f32x4*)(g0 + col); C[k] = *(const f32x4*)(gp1 + col); U[k] = *(const f32x4*)(Uedge + ((size_t)pm * 2 + bot) * DFF + col);
            X0[k] = *(const f32x4*)(cw + col); X1[k] = *(const f32x4*)(cw + DFF + col); X2[k] = *(const f32x4*)(cw + 2 * DFF + col); X3[k] = *(const f32x4*)(cb + col);
            dst[k] = Aout + (size_t)(r0 + (bot ? 255 : 0)) * DFF + col;
        }
#pragma unroll
        for (int k = 0; k < 3; ++k) {
            float o[4];
#pragma unroll
            for (int e = 0; e < 4; ++e) { const float z = X3[k][e] + X0[k][e] * A[k][e] + X1[k][e] * B[k][e] + X2[k][e] * C[k][e]; o[e] = silu_f(z) * U[k][e]; }
            u32x2 w; w.x = cvt_pk_bf16(o[0], o[1]); w.y = cvt_pk_bf16(o[2], o[3]);
            if (ok[k]) *(u32x2*)dst[k] = w;
        }
    }
}
struct LocPlain { bf16_t* base; int ld;
    __device__ __forceinline__ void operator()(const pg8::Unit& u, int bj, bf16_t*& p, int& l) const { p = base + (size_t)u.pm * 256 * ld + u.pn * 256 + bj * 128; l = ld; } };
struct LocSplit { bf16_t* YP;
    __device__ __forceinline__ void operator()(const pg8::Unit& u, int bj, bf16_t*& p, int& l) const { p = YP + (size_t)u.kind * NCTX * DM + (size_t)u.pm * 256 * DM + u.pn * 256 + bj * 128; l = DM; } };
struct LocZ { bf16_t* CC; int row0, mul;
    __device__ __forceinline__ void operator()(const pg8::Unit& u, int bj, bf16_t*& p, int& l) const { p = CC + (size_t)(row0 + (u.pn >> 1) * mul + u.pm * 256) * KP + 1536 + (u.pn & 1) * 256 + bj * 128; l = KP; } };

__device__ __forceinline__ void attn_phase(const bf16_t* P, bf16_t* CC, const float* sink, bool do_ctx, int c, int G, char* lds, const int wave_s) {
    const int NU = 1024 + 512 + (do_ctx ? 96 : 0);
    for (int F0 = c; F0 < NU; F0 += G) {
        att::AUnit U; int F = F0;
        if (F < 1024) {
            const int i = F >> 8, cc = F & 255, xcd = cc & 7, uid = i * 32 + (cc >> 3);
            const int pair = xcd * 2 + (uid >> 6), g = (uid & 63) >> 4, qb = uid & 15, b = pair >> 1, kvh = pair & 1, h = kvh * 4 + g;
            U.q = P + (size_t)(b * SEQ + qb * 256) * PW + h * 128;
            U.k0 = P + (size_t)(b * SEQ) * PW + 1536 + kvh * 128; U.n0 = SEQ / 64;
            U.k1 = P + (size_t)(NLAT + b * CTXL) * PW + 1536 + kvh * 128;
            U.o = CC + (size_t)(b * SEQ + qb * 256) * KP + h * 128; U.win = 0; U.qk_off = 0; U.m0 = -1e30f; U.l0 = 0.f;
        } else if (F < 1536) {
            F -= 1024;
            const int i = F >> 8, cc = F & 255, xcd = cc & 7, uid = i * 32 + (cc >> 3);
            const int pair = xcd * 2 + (uid >> 5), g = (uid & 31) >> 4, qb = uid & 15, b = pair >> 1, kvh = pair & 1, h = kvh * 2 + g;
            const int q0 = qb * 256, ks = q0 >= 128 ? q0 - 128 : 0, ke = q0 + 384 <= SEQ ? q0 + 384 : SEQ;
            U.q = P + (size_t)(b * SEQ + q0) * PW + 1024 + h * 128;
            U.k0 = P + (size_t)(b * SEQ + ks) * PW + 2048 + kvh * 128; U.n0 = (ke - ks) / 64;
            U.k1 = P + (size_t)(NLAT + b * CTXL) * PW + 2048 + kvh * 128;
            U.o = CC + (size_t)(b * SEQ + q0) * KP + 1024 + h * 128; U.win = 1; U.qk_off = q0 - ks; U.m0 = sink[h] * (1.0f / att::SCALE); U.l0 = 1.f;
        } else {
            F -= 1536; U.k0 = P; U.n0 = 0; U.win = 0; U.qk_off = 0;
            if (F < 64) { const int b = F >> 3, h = F & 7, kvh = h >> 2; const bf16_t* rowp = P + (size_t)(NLAT + b * CTXL) * PW;
                U.q = rowp + h * 128; U.k1 = rowp + 1536 + kvh * 128; U.o = CC + (size_t)(NLAT + b * CTXL) * KP + h * 128; U.m0 = -1e30f; U.l0 = 0.f; }
            else { const int f2 = F - 64, b = f2 >> 2, h = f2 & 3, kvh = h >> 1; const bf16_t* rowp = P + (size_t)(NLAT + b * CTXL) * PW;
                U.q = rowp + 1024 + h * 128; U.k1 = rowp + 2048 + kvh * 128; U.o = CC + (size_t)(NLAT + b * CTXL) * KP + 1024 + h * 128; U.m0 = sink[h] * (1.0f / att::SCALE); U.l0 = 1.f; }
        }
        if (U.win) att::attn_unit<true>(U, lds, wave_s); else att::attn_unit<false>(U, lds, wave_s);
    }
}

#ifndef PHMASK
#define PHMASK 0xFFFF
#endif
#define REP_P0 1
#define REP_A 1
#define REP_C1 1
#define REP_C2 1
#define REP_D 1
#define REP_F 1
#define REP_H 1
__global__ void __launch_bounds__(NTHR, 2) fwd(Args a_unused) {
    extern __shared__ __attribute__((aligned(16))) unsigned char lds[];
    LAS unsigned char* L = (LAS unsigned char*)lds;
    const int G = gridDim.x, c = blockIdx.x;
    const int wave_s = __builtin_amdgcn_readfirstlane(threadIdx.x >> 6);
#define LANE (tid & 63)
#define WAVE wave_s
#define VCU ((G % 8 == 0) ? (c % 8) * (G / 8) + c / 8 : c)
#define GW (VCU * NWAVES + WAVE)
#define NGW (G * NWAVES)
#define GT (c * NTHR + tid)
#define NGT (G * NTHR)
    for (int u = threadIdx.x; u < (LDS_BYTES - 131072) / 4; u += NTHR) ((LAS unsigned*)(L + 131072))[u] = 0u;
    __syncthreads();
    (void)xcd_barrier_post((unsigned*)(ARG_WS + WS_CTL) + CW_BAR, (volatile LAS unsigned*)(L + MISC_OFF) + 8);
#define GRID_BAR() do { XcdBarrier bar_; bar_.bar = (unsigned*)(ARG_WS + WS_CTL) + CW_BAR; bar_.x = xb_xcc_id(); bar_.st = (volatile LAS unsigned*)(L + MISC_OFF) + 8; xcd_barrier(bar_, otid() == 0); } while (0)

    {
    const int tid = otid();
#if PHMASK & 1
    for (int rep_ = 0; rep_ < REP_P0; ++rep_) { __syncthreads();
    p0_mod(ARG_IN(I_C), ARG_IN(I_CCTX), ARG_IN(I_WMOD), (float*)(ARG_WS + WS_MODP), (LAS float*)L, GW, NGW, tid, LANE);
    p0_fold_f(c, G, tid);
    p0_fold_o((LAS float*)L, c, G, tid);
    p0_tables(GT, NGT);
    p0_transposes((LAS float*)(L + WAVE * 8448), GW, NGW, LANE);
    }
#endif
    }
    GRID_BAR();
    { const int tid = otid(); p0_mod_reduce(GT, NGT); }
    GRID_BAR();
    { const int tid = otid(); unsigned char* ws = ARG_WS; const float* mod = (const float*)(ws + WS_MOD);
      rowpass<false, true, false, false>(ARG_IN(I_X), ARG_IN(I_CTX), nullptr, nullptr, nullptr, nullptr, (bf16_t*)(ws + WS_H), nullptr, nullptr, nullptr, mod + 0 * DM, mod + 1 * DM, true, (LAS float*)L, c, G, tid, WAVE, LANE); }
    GRID_BAR();

    for (int l = 0; l < DEPTH; ++l) {
        const bool last = (l == DEPTH - 1);
#if PHMASK & 2
        for (int rep_ = 0; rep_ < REP_A; ++rep_)
        {
            unsigned char* ws = ARG_WS; const unsigned char* wl = ws + WS_W + (size_t)l * WL_STRIDE; const bf16_t* H = (const bf16_t*)(ws + WS_H);
            pg8::InOrder S{H, (const bf16_t*)(wl + WL_IN), (const bf16_t*)(wl + WL_FH), (const bf16_t*)(wl + WL_F), G, c};
            pg8::EpiIn E{(bf16_t*)(ws + WS_P), (bf16_t*)(ws + WS_UT), (bf16_t*)(ws + WS_UTC), ARG_IN(I_QG) + l * HD, ARG_IN(I_KG) + l * HD, (const f32x2*)(ws + WS_ROPE), L + XL_OFF};
            pg8::gemm_phase<pg8::EpiIn, pg8::InOrder>(L, DM, KP, S, E, wave_s);
        }
#endif
        GRID_BAR();
#if PHMASK & 4
        { const int tid = otid(); unsigned char* ws = ARG_WS; fold_pass((const bf16_t*)(ws + WS_UT), (bf16_t*)(ws + WS_UTF), (float*)(ws + WS_C2048), GW, NGW, LANE); }
#endif
        GRID_BAR();
#if PHMASK & 8
        for (int rep_ = 0; rep_ < REP_C1; ++rep_)
        { unsigned char* ws = ARG_WS; attn_phase((const bf16_t*)(ws + WS_P), (bf16_t*)(ws + WS_CC), ARG_IN(I_SINK) + l * 4, !last, c, G, (char*)lds, wave_s); }
#endif
#if PHMASK & 16
        for (int rep_ = 0; rep_ < REP_C2; ++rep_)
        {
            unsigned char* ws = ARG_WS;
            pg8::MultiOrder S; S.init((const bf16_t*)(ws + WS_DFT), (const bf16_t*)(ws + WS_UTF), SEQ, NB * 512, nullptr, nullptr, 0, 0, SEQ, G, c); S.WGM = WGM_Z;
            pg8::EpiZ E{(bf16_t*)(ws + WS_CC), (const float*)(ws + WS_C2048)};
            pg8::gemm_phase<pg8::EpiZ, pg8::MultiOrder>(L, SEQ, SEQ, S, E, wave_s);
        }
#endif
#if PHMASK & 1024
        if (!last) {
            unsigned char* ws = ARG_WS;
            pg8::MultiOrder S; S.init((const bf16_t*)(ws + WS_DFTC), (const bf16_t*)(ws + WS_UTC), CTXL, NB * 512, nullptr, nullptr, 0, 0, 2 * CTXL, G, (c + G - 96 % G) % G);
            pg8::EpiStore<LocZ> E{LocZ{(bf16_t*)(ws + WS_CC), NLAT, CTXL}};
            pg8::gemm_phase<pg8::EpiStore<LocZ>, pg8::MultiOrder>(L, 2 * CTXL, 2 * CTXL, S, E, wave_s);
        }
#endif
        GRID_BAR();
#if PHMASK & 32
        for (int rep_ = 0; rep_ < REP_D; ++rep_)
        {
            unsigned char* ws = ARG_WS; const unsigned char* wl = ws + WS_W + (size_t)l * WL_STRIDE;
            pg8::MultiOrder S; S.init((const bf16_t*)(ws + WS_CC), (const bf16_t*)(wl + WL_OUT), NLAT, DM, nullptr, nullptr, 0, 0, KP, G, c); S.WGM = WGM_D;
            pg8::EpiStore<LocPlain> E{LocPlain{(bf16_t*)(ws + WS_Y), DM}};
            pg8::gemm_phase<pg8::EpiStore<LocPlain>, pg8::MultiOrder>(L, DM, KP, S, E, wave_s);
            if (!last) {
                pg8::SplitKOrder S2{(const bf16_t*)(ws + WS_CC) + (size_t)NLAT * KP, (const bf16_t*)(wl + WL_OUT), KP, DM / 4, G, c};
                pg8::EpiStore<LocSplit> E2{LocSplit{(bf16_t*)(ws + WS_YP)}};
                pg8::gemm_phase<pg8::EpiStore<LocSplit>, pg8::SplitKOrder>(L, DM / 4, KP, S2, E2, wave_s);
            }
        }
#endif
        GRID_BAR();
#if PHMASK & 64
        {
            const int tid = otid(); unsigned char* ws = ARG_WS; const float* modl = (const float*)(ws + WS_MOD) + (size_t)l * NMODROW * MODW; void* XC = (void*)(ws + WS_XC); void* XH = (void*)(ws + WS_XH);
            if (l == 0) rowpass<true, true, false, true>(ARG_IN(I_X), ARG_IN(I_CTX), XH, XC, (const bf16_t*)(ws + WS_Y), (const bf16_t*)(ws + WS_YP), (bf16_t*)(ws + WS_H), modl + 2 * DM, ARG_IN(I_LN1G) + l * DM, ARG_IN(I_LN1B) + l * DM,
                                modl + 3 * DM, modl + 4 * DM, !last, (LAS float*)L, c, G, tid, WAVE, LANE);
            else rowpass<true, true, true, true>(XH, XC, XH, XC, (const bf16_t*)(ws + WS_Y), (const bf16_t*)(ws + WS_YP), (bf16_t*)(ws + WS_H), modl + 2 * DM, ARG_IN(I_LN1G) + l * DM, ARG_IN(I_LN1B) + l * DM,
                                modl + 3 * DM, modl + 4 * DM, !last, (LAS float*)L, c, G, tid, WAVE, LANE);
        }
#endif
        GRID_BAR();
#if PHMASK & 128
        for (int rep_ = 0; rep_ < REP_F; ++rep_)
        {
            unsigned char* ws = ARG_WS; const unsigned char* wl = ws + WS_W + (size_t)l * WL_STRIDE;
            pg8::MultiOrder S; S.init((const bf16_t*)(ws + WS_H), (const bf16_t*)(wl + WL_GU), last ? NLAT : NTOK, 2 * DFF, nullptr, nullptr, 0, 0, KP, G, c); S.WGM = WGM_F;
            pg8::EpiConv E{(bf16_t*)(ws + WS_U), (float*)(ws + WS_GEDGE), (float*)(ws + WS_UEDGE), ARG_IN(I_CONVW) + (size_t)l * 3 * DFF, ARG_IN(I_CONVB) + (size_t)l * DFF, L + XL_OFF};
            pg8::gemm_phase<pg8::EpiConv, pg8::MultiOrder>(L, DM, KP, S, E, wave_s);
        }
#endif
        GRID_BAR();
#if PHMASK & 256
        { const int tid = otid(); unsigned char* ws = ARG_WS; conv_fix((bf16_t*)(ws + WS_U), (const float*)(ws + WS_GEDGE), (const float*)(ws + WS_UEDGE), ARG_IN(I_CONVW) + (size_t)l * 3 * DFF, ARG_IN(I_CONVB) + (size_t)l * DFF, (last ? NLAT : NTOK) / 256, GT, NGT); }
#endif
        GRID_BAR();
#if PHMASK & 512
        for (int rep_ = 0; rep_ < REP_H; ++rep_)
        {
            unsigned char* ws = ARG_WS; const unsigned char* wl = ws + WS_W + (size_t)l * WL_STRIDE;
            pg8::MultiOrder S; S.init((const bf16_t*)(ws + WS_U), (const bf16_t*)(wl + WL_DN), NLAT, DM, nullptr, nullptr, 0, 0, DFF, G, c); S.WGM = WGM_H;
            pg8::EpiStore<LocPlain> E{LocPlain{(bf16_t*)(ws + WS_Y), DM}};
            pg8::gemm_phase<pg8::EpiStore<LocPlain>, pg8::MultiOrder>(L, DFF, DFF, S, E, wave_s);
            if (!last) {
                pg8::SplitKOrder S2{(const bf16_t*)(ws + WS_U) + (size_t)NLAT * DFF, (const bf16_t*)(wl + WL_DN), DFF, DFF / 4, G, c};
                pg8::EpiStore<LocSplit> E2{LocSplit{(bf16_t*)(ws + WS_YP)}};
                pg8::gemm_phase<pg8::EpiStore<LocSplit>, pg8::SplitKOrder>(L, DFF / 4, DFF, S2, E2, wave_s);
            }
        }
#endif
        GRID_BAR();
        {
            const int tid = otid(); unsigned char* ws = ARG_WS; const float* modl = (const float*)(ws + WS_MOD) + (size_t)l * NMODROW * MODW; void* XC = (void*)(ws + WS_XC); void* XH = (void*)(ws + WS_XH);
            if (!last) rowpass<true, true, true, true>(XH, XC, XH, XC, (const bf16_t*)(ws + WS_Y), (const bf16_t*)(ws + WS_YP), (bf16_t*)(ws + WS_H), modl + 5 * DM, ARG_IN(I_LN2G) + l * DM, ARG_IN(I_LN2B) + l * DM,
                                           modl + NMODROW * MODW + 0 * DM, modl + NMODROW * MODW + 1 * DM, true, (LAS float*)L, c, G, tid, WAVE, LANE);
            else rowpass<true, false, true, false>(XH, XC, ARG_OUT, XC, (const bf16_t*)(ws + WS_Y), (const bf16_t*)(ws + WS_YP), (bf16_t*)(ws + WS_H), modl + 5 * DM, ARG_IN(I_LN2G) + l * DM, ARG_IN(I_LN2B) + l * DM, nullptr, nullptr, false, (LAS float*)L, c, G, tid, WAVE, LANE);
        }
        if (!last) GRID_BAR();
    }
}

extern "C" void kernel_launch(void* const* d_in, const int* in_sizes, int n_in, void* d_out, int out_size, void* d_ws, size_t ws_size, hipStream_t stream) {
    static int grid = 0;
    if (grid == 0) {
        if (n_in != 21 || out_size != NLAT * DM || ws_size < WS_END) { fprintf(stderr, "kernel_launch: unexpected shapes (n_in %d out %d ws %zu, need ws >= %zu)\n", n_in, out_size, ws_size, (size_t)WS_END); grid = -1; return; }
        int dev = 0, cus = 0, per_cu = 0;
        if (hipGetDevice(&dev) != hipSuccess || hipDeviceGetAttribute(&cus, hipDeviceAttributeMultiprocessorCount, dev) != hipSuccess) { grid = -1; return; }
        if (hipFuncSetAttribute((const void*)fwd, hipFuncAttributeMaxDynamicSharedMemorySize, LDS_BYTES) != hipSuccess) { fprintf(stderr, "kernel_launch: hipFuncSetAttribute failed\n"); grid = -1; return; }
        if (hipOccupancyMaxActiveBlocksPerMultiprocessor(&per_cu, (const void*)fwd, NTHR, LDS_BYTES) != hipSuccess || per_cu < 1) { fprintf(stderr, "kernel_launch: occupancy query says %d blocks per CU\n", per_cu); }
        (void)hipGetLastError();
        grid = cus;
    }
    if (grid < 0) return;
    if (hipMemsetAsync((char*)d_ws + WS_CTL, 0, CTL_ZERO_BYTES, stream) != hipSuccess) return;
    Args a{};
    for (int i = 0; i < 21; ++i) a.in[i] = (const float*)d_in[i];
    a.out = (float*)d_out; a.ws = (unsigned char*)d_ws;
    hipLaunchKernelGGL(fwd, dim3(grid), dim3(NTHR), LDS_BYTES, stream, a);
}
```
